# Optimizing an MI355X kernel written in HIP

```python
import jax, jax.numpy as jnp
from jax import lax
import numpy as np

D_MODEL = 1024
BATCH = 2
SEQ = 16384
DEPTH = 2

D_PLE = 256
HEAD_DIM = 64
N_HEADS_SGU = 4
N_HEADS_RET = 6
N_HEADS_FOX = 6
W_SGU = N_HEADS_SGU * HEAD_DIM
W_RET = N_HEADS_RET * HEAD_DIM
W_FOX = N_HEADS_FOX * HEAD_DIM
D_MIX = W_SGU + W_RET + W_FOX
CHUNK = 128
D_FF = 4 * D_MODEL
CONV_WIDTH = 3
ROPE_BASE = 10000.0
RMS_EPS = 1e-6
IN_SPLIT_SIZES = (W_SGU, W_SGU, W_RET, W_RET, W_RET, W_RET, W_FOX, W_FOX, W_FOX, N_HEADS_FOX)
N_IN = sum(IN_SPLIT_SIZES)
IN_SPLIT_POINTS = tuple(int(v) for v in np.cumsum(IN_SPLIT_SIZES)[:-1])

kernel_name = "hymba_style_sgu_retention_fox_block"


def rmsnorm(x, g):
    xf = x.astype(jnp.float32)
    y = xf * lax.rsqrt(jnp.mean(xf * xf, axis=-1, keepdims=True) + RMS_EPS)
    return (y * g.astype(jnp.float32)).astype(x.dtype)


def rotary(t, positions):
    half = t.shape[-1] // 2
    inv_freq = ROPE_BASE ** (-jnp.arange(half, dtype=jnp.float32) / half)
    ang = positions.astype(jnp.float32)[..., None] * inv_freq
    cos = jnp.cos(ang)[:, :, None, :]
    sin = jnp.sin(ang)[:, :, None, :]
    t1, t2 = t[..., :half], t[..., half:]
    return jnp.concatenate([t1 * cos - t2 * sin, t1 * sin + t2 * cos], axis=-1)


def spatial_gating(u, v, v_gain, w_s, b_s):
    B, S, H, D = v.shape
    nc = S // CHUNK
    v = rmsnorm(v, v_gain).reshape(B, nc, CHUNK, H, D)
    causal = jnp.tril(jnp.ones((CHUNK, CHUNK), dtype=bool))
    w = jnp.where(causal[None], w_s, jnp.zeros_like(w_s))
    s = jnp.einsum('hts,bnshd->bnthd', w, v) + b_s.T[None, None, :, :, None]
    return u * s.reshape(B, S, H, D)


def retention_chunkwise(q, k, v):
    B, S, H, D = q.shape
    nc = S // CHUNK
    log_g = jnp.log(1.0 - 2.0 ** (-5.0 - jnp.arange(H, dtype=jnp.float32)))
    idx = jnp.arange(CHUNK, dtype=jnp.float32)
    diff = idx[:, None] - idx[None, :]
    decay = jnp.where(diff >= 0, jnp.exp(log_g[:, None, None] * jnp.maximum(diff, 0.0)), 0.0)
    q_decay = jnp.exp(log_g[:, None] * (idx + 1.0))[None, :, :, None]
    k_decay = jnp.exp(log_g[:, None] * (CHUNK - 1.0 - idx))[None, :, :, None]
    chunk_decay = jnp.exp(log_g * CHUNK)[None, :, None, None]

    def to_chunks(t):
        return t.reshape(B, nc, CHUNK, H, D).transpose(1, 0, 3, 2, 4)

    def step(R, inp):
        q_i, k_i, v_i = inp
        inner = jnp.einsum('bhtd,bhsd->bhts', q_i, k_i) * decay
        o = jnp.einsum('bhts,bhse->bhte', inner, v_i)
        o = o + jnp.einsum('bhtd,bhde->bhte', q_i, R) * q_decay
        R = R * chunk_decay + jnp.einsum('bhsd,bhse->bhde', k_i * k_decay, v_i)
        return R, o

    R0 = jnp.zeros((B, H, D, D), dtype=jnp.float32)
    _, o = lax.scan(step, R0, (to_chunks(q), to_chunks(k), to_chunks(v)))
    return o.transpose(1, 0, 3, 2, 4).reshape(B, S, H, D)


def forgetting_attention(q, k, v, log_f):
    B, S, H, D = q.shape
    nb = S // CHUNK
    scale = D ** -0.5
    c = jnp.cumsum(log_f, axis=1)
    cT = c.transpose(0, 2, 1)
    qb = q.reshape(B, nb, CHUNK, H, D).transpose(1, 0, 2, 3, 4)
    cb = cT.reshape(B, H, nb, CHUNK).transpose(2, 0, 1, 3)
    starts = jnp.arange(nb, dtype=jnp.int32) * CHUNK
    key_pos = jnp.arange(S, dtype=jnp.int32)

    def one_block(args):
        q_i, c_i, start = args
        s = jnp.einsum('bqhd,bkhd->bhqk', q_i, k).astype(jnp.float32) * scale
        s = s + c_i[..., None] - cT[:, :, None, :]
        q_pos = start + jnp.arange(CHUNK, dtype=jnp.int32)
        mask = key_pos[None, :] <= q_pos[:, None]
        s = jnp.where(mask[None, None], s, -jnp.inf)
        prob = jax.nn.softmax(s, axis=-1)
        return jnp.einsum('bhqk,bkhd->bqhd', prob.astype(v.dtype), v)

    out = lax.map(one_block, (qb, cb, starts))
    return out.transpose(1, 0, 2, 3, 4).reshape(B, S, H, D)


def conv_gated_mlp(h, w_gate, w_up, conv_w, conv_b, w_down):
    S = h.shape[1]
    g = h @ w_gate
    gp = jnp.pad(g, ((0, 0), (CONV_WIDTH - 1, 0), (0, 0)))
    conv = conv_b + gp[:, 0:S] * conv_w[0]
    for j in range(1, CONV_WIDTH):
        conv = conv + gp[:, j:j + S] * conv_w[j]
    act = jax.nn.gelu(conv, approximate=True) * (h @ w_up)
    return act @ w_down


def setup_inputs(seed: int = 0) -> dict:
    key = jax.random.key(seed)
    ks = jax.random.split(key, 24)
    f32 = jnp.float32

    def nrm(k, shape, scale):
        return jax.random.normal(k, shape, f32) * scale

    def gain(k, shape):
        return 1.0 + 0.05 * jax.random.normal(k, shape, f32)

    return {
        "x": nrm(ks[0], (BATCH, SEQ, D_MODEL), 1.0),
        "p": nrm(ks[1], (DEPTH, BATCH, SEQ, D_PLE), 1.0),
        "positions": jnp.broadcast_to(jnp.arange(SEQ, dtype=jnp.int32)[None, :], (BATCH, SEQ)),
        "mix_pre_g": gain(ks[2], (DEPTH, D_MODEL)),
        "w_in": nrm(ks[3], (DEPTH, D_MODEL, N_IN), D_MODEL ** -0.5),
        "sgu_v_g": gain(ks[4], (DEPTH, N_HEADS_SGU, HEAD_DIM)),
        "sgu_w": nrm(ks[5], (DEPTH, N_HEADS_SGU, CHUNK, CHUNK), CHUNK ** -0.5),
        "sgu_b": 1.0 + 0.01 * jax.random.normal(ks[6], (DEPTH, N_HEADS_SGU, CHUNK), f32),
        "fox_b_f": 3.0 + 0.5 * jax.random.normal(ks[7], (DEPTH, N_HEADS_FOX), f32),
        "w_o": nrm(ks[8], (DEPTH, D_MIX, D_MODEL), D_MIX ** -0.5),
        "mix_post_g": gain(ks[9], (DEPTH, D_MODEL)),
        "ffn_pre_g": gain(ks[10], (DEPTH, D_MODEL)),
        "w_gate": nrm(ks[11], (DEPTH, D_MODEL, D_FF), D_MODEL ** -0.5),
        "w_up": nrm(ks[12], (DEPTH, D_MODEL, D_FF), D_MODEL ** -0.5),
        "conv_w": nrm(ks[13], (DEPTH, CONV_WIDTH, D_FF), CONV_WIDTH ** -0.5),
        "conv_b": nrm(ks[14], (DEPTH, D_FF), 0.01),
        "w_down": nrm(ks[15], (DEPTH, D_FF, D_MODEL), D_FF ** -0.5),
        "ffn_post_g": gain(ks[16], (DEPTH, D_MODEL)),
        "ple_pre_g": gain(ks[17], (DEPTH, D_MODEL)),
        "w_ple_gate": nrm(ks[18], (DEPTH, D_MODEL, D_MODEL), D_MODEL ** -0.5),
        "w_ple_proj": nrm(ks[19], (DEPTH, D_PLE, D_MODEL), D_PLE ** -0.5),
        "ple_post_g": gain(ks[20], (DEPTH, D_MODEL)),
    }


def reference(x, p, positions, mix_pre_g, w_in, sgu_v_g, sgu_w, sgu_b, fox_b_f, w_o,
              mix_post_g, ffn_pre_g, w_gate, w_up, conv_w, conv_b, w_down, ffn_post_g,
              ple_pre_g, w_ple_gate, w_ple_proj, ple_post_g):
    B, S, _ = x.shape
    dt = x.dtype
    for i in range(DEPTH):
        h = rmsnorm(x, mix_pre_g[i])
        z = h @ w_in[i]
        (a_u, a_v, r_q, r_k, r_v, r_g,
         f_q, f_k, f_v, f_f) = jnp.split(z, IN_SPLIT_POINTS, axis=-1)

        a_u = jax.nn.gelu(a_u, approximate=True).reshape(B, S, N_HEADS_SGU, HEAD_DIM)
        a_v = jax.nn.gelu(a_v, approximate=True).reshape(B, S, N_HEADS_SGU, HEAD_DIM)
        out_a = spatial_gating(a_u, a_v, sgu_v_g[i], sgu_w[i], sgu_b[i]).reshape(B, S, W_SGU)

        rq = rotary(r_q.astype(jnp.float32).reshape(B, S, N_HEADS_RET, HEAD_DIM), positions)
        rk = rotary(r_k.astype(jnp.float32).reshape(B, S, N_HEADS_RET, HEAD_DIM), positions) * (HEAD_DIM ** -0.5)
        rv = r_v.astype(jnp.float32).reshape(B, S, N_HEADS_RET, HEAD_DIM)
        ro = retention_chunkwise(rq, rk, rv)
        ro = ro * lax.rsqrt(jnp.mean(ro * ro, axis=-1, keepdims=True) + RMS_EPS)
        out_b = (jax.nn.silu(r_g.astype(jnp.float32)) * ro.reshape(B, S, W_RET)).astype(dt)

        log_f = jax.nn.log_sigmoid(f_f.astype(jnp.float32) + fox_b_f[i].astype(jnp.float32))
        out_c = forgetting_attention(
            f_q.reshape(B, S, N_HEADS_FOX, HEAD_DIM),
            f_k.reshape(B, S, N_HEADS_FOX, HEAD_DIM),
            f_v.reshape(B, S, N_HEADS_FOX, HEAD_DIM),
            log_f).reshape(B, S, W_FOX).astype(dt)

        mix = jnp.concatenate([out_a.astype(dt), out_b, out_c], axis=-1) @ w_o[i]
        x = x + rmsnorm(mix, mix_post_g[i])

        h = rmsnorm(x, ffn_pre_g[i])
        f = conv_gated_mlp(h, w_gate[i], w_up[i], conv_w[i], conv_b[i], w_down[i])
        x = x + rmsnorm(f, ffn_post_g[i])

        gate = jax.nn.sigmoid(rmsnorm(x, ple_pre_g[i]) @ w_ple_gate[i])
        e = p[i] @ w_ple_proj[i]
        x = x + rmsnorm(e * gate, ple_post_g[i])
    return x
```

```cpp
#include <hip/hip_runtime.h>
#include <hip/hip_cooperative_groups.h>
#include <cstdio>
#include <cstdint>
#include <cmath>
#include <cstring>
namespace cg = cooperative_groups;
namespace pg8 {
#define PG8_LAS __attribute__((address_space(3)))
typedef unsigned short bf16_t;
typedef short bf16x8 __attribute__((ext_vector_type(8)));
typedef float f32x4 __attribute__((ext_vector_type(4)));
typedef unsigned u32x4 __attribute__((ext_vector_type(4)));
constexpr int BM = 256, BK = 64, HALF = 128, HTB = HALF * BK * 2  , STAGE_BYTES = 8 * HTB, NXCD = 8, WGM = 8;

__host__ __device__ __forceinline__ int lds_byte(int r, int c) { const int st = (r >> 4) * 2 + (c >> 5), rr = r & 15, cc = c & 31, ob = rr * 64 + cc * 2; return st * 1024 + (ob ^ (((ob >> 9) & 1) << 5)); }
__host__ __device__ __forceinline__ void stage_rc(int b, int& R, int& C) { const int st = b / 1024, sb = b % 1024, swz = sb ^ (((sb >> 9) & 1) << 5); R = (st >> 1) * 16 + swz / 64; C = (st & 1) * 32 + (swz % 64) / 2; }
__host__ __device__ __forceinline__ int perm32(int rho) { const int n = rho >> 4, i = rho & 15; return 8 * (i >> 2) + 4 * n + (i & 3); }

struct Unit { int pm, pn; };
struct Gemm { const bf16_t* A; const bf16_t* Bt; int M, N, K; };

struct StaticOrder {
    int nM, nN, nwg, G, c;
    __host__ __device__ void init(int M, int N, int G_, int c_) { nM = M / BM; nN = N / BM; nwg = nM * nN; G = G_; c = c_; }
    __host__ __device__ bool next(int i, Unit& u) const {
        const long L = (long)i * G + c; if (L >= nwg) return false;
        int wgid = (int)L; { const int q = nwg / NXCD, r = nwg % NXCD, xcd = wgid % NXCD, off = wgid / NXCD; wgid = (xcd < r ? xcd * (q + 1) : r * (q + 1) + (xcd - r) * q) + off; }
        const int nig = WGM * nN, gid = wgid / nig, fm = gid * WGM, gsz = (nM - fm) < WGM ? (nM - fm) : WGM;
        u.pm = fm + ((wgid % nig) % gsz); u.pn = (wgid % nig) / gsz; return true;
    }
    __device__ __forceinline__ void a_ready(const Unit&) const {}
    __device__ __forceinline__ void done(const Unit&) const {}
};

__device__ __forceinline__ unsigned cvt_pk_bf16(float lo, float hi) { unsigned r; asm volatile("v_cvt_pk_bf16_f32 %0, %1, %2" : "=v"(r) : "v"(lo), "v"(hi)); return r; }
typedef float f32x2 __attribute__((ext_vector_type(2)));
__device__ __forceinline__ f32x2 gelu_pk(f32x2 v) {
    const f32x2 av = __builtin_elementwise_abs(v), d = av * 0.2316418882f + 1.0f;
    f32x2 t; t.x = __builtin_amdgcn_rcpf(d.x); t.y = __builtin_amdgcn_rcpf(d.y);
    f32x2 q = t * 0.5307027145f + (-0.7265760135f); q = q * t + 0.7107068705f; q = q * t + (-0.142248368f); q = q * t + 0.127414796f; q = q * t;
    const f32x2 s = (v * v) * (-0.72134752044f);
    f32x2 e; e.x = __builtin_amdgcn_exp2f(s.x); e.y = __builtin_amdgcn_exp2f(s.y);
    const f32x2 m = v * (q * e), r = v - m;
    f32x2 o; o.x = v.x < 0.f ? m.x : r.x; o.y = v.y < 0.f ? m.y : r.y; return o;
}

template <int ACT  > struct EpiBf16 {
    static constexpr bool PERM = true, AFTER_DRAIN = false; static_assert(ACT == 0 || ACT == 1, "EpiBf16: ACT is 0 (none) or 1 (gelu_pk)");
    bf16_t* O; int ldc; const float* bias; int split_cols; size_t split_stride; float scale0;
    __device__ __forceinline__ void operator()(const f32x4 (&acc)[2][2][4][2], const Unit& u, int wr, int wc, int fr, int fq) const {
        const int row0 = u.pm * BM + wr * 64 + fr; int colt = u.pn * BM; bf16_t* base = O;
        float sc = 1.f; if (split_cols) { const int t = colt / split_cols; base += (size_t)t * split_stride; colt -= t * split_cols; if (t == 0) sc = scale0; }
        const int col0 = colt + wc * 32 + 8 * fq, bcol0 = u.pn * BM + wc * 32 + 8 * fq;
        f32x4 bv[2][2];
#pragma unroll
        for (int bj = 0; bj < 2; ++bj)
#pragma unroll
            for (int n = 0; n < 2; ++n) bv[bj][n] = bias ? *(const f32x4*)(bias + bcol0 + bj * HALF + 4 * n) : (f32x4){0.f, 0.f, 0.f, 0.f};
#pragma unroll
        for (int ai = 0; ai < 2; ++ai)
#pragma unroll
            for (int m = 0; m < 4; ++m) { bf16_t* rowp = base + (size_t)(row0 + ai * HALF + m * 16) * ldc + col0;
#pragma unroll
                for (int bj = 0; bj < 2; ++bj) { f32x4 v0 = acc[ai][bj][m][0] + bv[bj][0], v1 = acc[ai][bj][m][1] + bv[bj][1];
                    if (ACT == 1) { f32x2 a = gelu_pk((f32x2){v0[0], v0[1]}), b = gelu_pk((f32x2){v0[2], v0[3]}), c = gelu_pk((f32x2){v1[0], v1[1]}), d = gelu_pk((f32x2){v1[2], v1[3]});
                        v0 = (f32x4){a.x, a.y, b.x, b.y}; v1 = (f32x4){c.x, c.y, d.x, d.y}; }
                    v0 = v0 * sc; v1 = v1 * sc; u32x4 w; w.x = cvt_pk_bf16(v0[0], v0[1]); w.y = cvt_pk_bf16(v0[2], v0[3]); w.z = cvt_pk_bf16(v1[0], v1[1]); w.w = cvt_pk_bf16(v1[2], v1[3]);
                    *(u32x4*)(rowp + bj * HALF) = w; } }
    }
};

typedef float f32x2_t __attribute__((ext_vector_type(2))); typedef __bf16 bf16x2_t __attribute__((ext_vector_type(2)));
__device__ __forceinline__ unsigned pk2(float lo, float hi) { f32x2_t v = {lo, hi}; bf16x2_t b = __builtin_convertvector(v, bf16x2_t); return __builtin_bit_cast(unsigned, b); }
__device__ __forceinline__ float bflo(unsigned w) { return __uint_as_float(w << 16); }
__device__ __forceinline__ float bfhi(unsigned w) { return __uint_as_float(w & 0xffff0000u); }
__device__ __forceinline__ float gelu_tanh(float x) { const float t = x * (1.0f + 0.044715f * x * x); return x * __builtin_amdgcn_rcpf(1.0f + __builtin_amdgcn_exp2f(-2.3022082f * t)); }
__device__ __forceinline__ float sigmoid_f(float x) { return __builtin_amdgcn_rcpf(1.0f + __builtin_amdgcn_exp2f(-1.4426950409f * x)); }
__device__ __forceinline__ float logsigmoid_f(float x) { return fminf(x, 0.f) - log1pf(__expf(-fabsf(x))); }
constexpr int ZP = 3328;
struct EpiZ {
    static constexpr bool PERM = true, AFTER_DRAIN = false;
    bf16_t* Z; const float* rinv; float* LF; const float* bfv;
    __device__ __forceinline__ void operator()(const f32x4 (&acc)[2][2][4][2], const Unit& u, int wr, int wc, int fr, int fq) const {
        const int row0 = u.pm * BM + wr * 64 + fr, colb = u.pn * BM + wc * 32 + 8 * fq; const bool dog = u.pn < 2; const bool dof = (u.pn == 12) && (wc == 0) && (fq == 0);
#pragma unroll
        for (int ai = 0; ai < 2; ++ai)
#pragma unroll
            for (int m = 0; m < 4; ++m) { const int row = row0 + ai * HALF + m * 16; const float sc = rinv[row]; bf16_t* rowp = Z + (size_t)row * ZP + colb;
#pragma unroll
                for (int bj = 0; bj < 2; ++bj) { f32x4 v0 = acc[ai][bj][m][0] * sc, v1 = acc[ai][bj][m][1] * sc;
                    if (dog) { v0[0] = gelu_tanh(v0[0]); v0[1] = gelu_tanh(v0[1]); v0[2] = gelu_tanh(v0[2]); v0[3] = gelu_tanh(v0[3]); v1[0] = gelu_tanh(v1[0]); v1[1] = gelu_tanh(v1[1]); v1[2] = gelu_tanh(v1[2]); v1[3] = gelu_tanh(v1[3]); }
                    u32x4 w; w.x = pk2(v0[0], v0[1]); w.y = pk2(v0[2], v0[3]); w.z = pk2(v1[0], v1[1]); w.w = pk2(v1[2], v1[3]);
                    *(u32x4*)(rowp + bj * HALF) = w;
                    if (bj == 1 && dof) { float* lf = LF + (size_t)row * 8;
                        lf[0] = logsigmoid_f(v0[0] + bfv[0]); lf[1] = logsigmoid_f(v0[1] + bfv[1]); lf[2] = logsigmoid_f(v0[2] + bfv[2]); lf[3] = logsigmoid_f(v0[3] + bfv[3]);
                        lf[4] = logsigmoid_f(v1[0] + bfv[4]); lf[5] = logsigmoid_f(v1[1] + bfv[5]); } } }
    }
};
struct EpiY {
    static constexpr bool PERM = true, AFTER_DRAIN = false;
    bf16_t* Y; float* ssq; int ldc;
    __device__ __forceinline__ void operator()(const f32x4 (&acc)[2][2][4][2], const Unit& u, int wr, int wc, int fr, int fq) const {
        const int row0 = u.pm * BM + wr * 64 + fr, colb = u.pn * BM + wc * 32 + 8 * fq;
#pragma unroll
        for (int ai = 0; ai < 2; ++ai)
#pragma unroll
            for (int m = 0; m < 4; ++m) { const int row = row0 + ai * HALF + m * 16; bf16_t* rowp = Y + (size_t)row * ldc + colb; float ss = 0.f;
#pragma unroll
                for (int bj = 0; bj < 2; ++bj) { const f32x4 v0 = acc[ai][bj][m][0], v1 = acc[ai][bj][m][1];
                    ss += (v0[0] * v0[0] + v0[1] * v0[1]) + (v0[2] * v0[2] + v0[3] * v0[3]) + (v1[0] * v1[0] + v1[1] * v1[1]) + (v1[2] * v1[2] + v1[3] * v1[3]);
                    u32x4 w; w.x = pk2(v0[0], v0[1]); w.y = pk2(v0[2], v0[3]); w.z = pk2(v1[0], v1[1]); w.w = pk2(v1[2], v1[3]);
                    *(u32x4*)(rowp + bj * HALF) = w; }
                ss += __shfl_xor(ss, 16); ss += __shfl_xor(ss, 32);
                if (fq == 0) ssq[(size_t)row * 16 + (u.pn & 3) * 4 + wc] = ss; }
    }
};
struct EpiS {
    static constexpr bool PERM = true, AFTER_DRAIN = false;
    bf16_t* O; const float* rinv; int ldc;
    __device__ __forceinline__ void operator()(const f32x4 (&acc)[2][2][4][2], const Unit& u, int wr, int wc, int fr, int fq) const {
        const int row0 = u.pm * BM + wr * 64 + fr, colb = u.pn * BM + wc * 32 + 8 * fq;
#pragma unroll
        for (int ai = 0; ai < 2; ++ai)
#pragma unroll
            for (int m = 0; m < 4; ++m) { const int row = row0 + ai * HALF + m * 16; const float sc = rinv ? rinv[row] : 1.0f; bf16_t* rowp = O + (size_t)row * ldc + colb;
#pragma unroll
                for (int bj = 0; bj < 2; ++bj) { const f32x4 v0 = acc[ai][bj][m][0] * sc, v1 = acc[ai][bj][m][1] * sc;
                    u32x4 w; w.x = pk2(v0[0], v0[1]); w.y = pk2(v0[2], v0[3]); w.z = pk2(v1[0], v1[1]); w.w = pk2(v1[2], v1[3]);
                    *(u32x4*)(rowp + bj * HALF) = w; } }
    }
};
struct EpiAct {
    static constexpr bool PERM = true, AFTER_DRAIN = false;
    bf16_t* ACT; const bf16_t* G; const float* rinv; const float* cw; const float* cb;
    __device__ __forceinline__ void operator()(const f32x4 (&acc)[2][2][4][2], const Unit& u, int wr, int wc, int fr, int fq) const {
        const int row0 = u.pm * BM + wr * 64 + fr, colb = u.pn * BM + wc * 32 + 8 * fq;
#pragma unroll
        for (int bj = 0; bj < 2; ++bj) { const int col = colb + bj * HALF;
            float w0[8], w1[8], w2[8], b0[8];
#pragma unroll
            for (int j = 0; j < 2; ++j) { const f32x4 a = *(const f32x4*)(cw + col + 4 * j), b = *(const f32x4*)(cw + 4096 + col + 4 * j), c = *(const f32x4*)(cw + 8192 + col + 4 * j), d = *(const f32x4*)(cb + col + 4 * j);
#pragma unroll
                for (int k = 0; k < 4; ++k) { w0[4 * j + k] = a[k]; w1[4 * j + k] = b[k]; w2[4 * j + k] = c[k]; b0[4 * j + k] = d[k]; } }
#pragma unroll
            for (int ai = 0; ai < 2; ++ai)
#pragma unroll
                for (int m = 0; m < 4; ++m) { const int row = row0 + ai * HALF + m * 16; const float sc = rinv[row];
                    const bf16_t* gp = G + (size_t)row * 4096 + col; const u32x4 z4 = {0u, 0u, 0u, 0u};
                    const u32x4 g2 = *(const u32x4*)gp; const u32x4 g1 = row >= 1 ? *(const u32x4*)(gp - 4096) : z4; const u32x4 g0 = row >= 2 ? *(const u32x4*)(gp - 8192) : z4;
                    float o[8];
#pragma unroll
                    for (int k = 0; k < 4; ++k) { const unsigned a = g0[k], b = g1[k], c = g2[k];
                        const float c0 = b0[2 * k] + w0[2 * k] * bflo(a) + w1[2 * k] * bflo(b) + w2[2 * k] * bflo(c);
                        const float c1 = b0[2 * k + 1] + w0[2 * k + 1] * bfhi(a) + w1[2 * k + 1] * bfhi(b) + w2[2 * k + 1] * bfhi(c);
                        const float u0 = (k < 2 ? acc[ai][bj][m][0][2 * k] : acc[ai][bj][m][1][2 * k - 4]) * sc, u1 = (k < 2 ? acc[ai][bj][m][0][2 * k + 1] : acc[ai][bj][m][1][2 * k - 3]) * sc;
                        o[2 * k] = gelu_tanh(c0) * u0; o[2 * k + 1] = gelu_tanh(c1) * u1; }
                    u32x4 w; w.x = pk2(o[0], o[1]); w.y = pk2(o[2], o[3]); w.z = pk2(o[4], o[5]); w.w = pk2(o[6], o[7]);
                    *(u32x4*)(ACT + (size_t)row * 4096 + col) = w; } }
    }
};
struct EpiPle {
    static constexpr bool PERM = true, AFTER_DRAIN = false;
    bf16_t* Y; const bf16_t* E; const float* rinv; float* ssq;
    __device__ __forceinline__ void operator()(const f32x4 (&acc)[2][2][4][2], const Unit& u, int wr, int wc, int fr, int fq) const {
        const int row0 = u.pm * BM + wr * 64 + fr, colb = u.pn * BM + wc * 32 + 8 * fq;
#pragma unroll
        for (int ai = 0; ai < 2; ++ai)
#pragma unroll
            for (int m = 0; m < 4; ++m) { const int row = row0 + ai * HALF + m * 16; const float sc = rinv[row]; float ss = 0.f;
#pragma unroll
                for (int bj = 0; bj < 2; ++bj) { const size_t off = (size_t)row * 1024 + colb + bj * HALF; const u32x4 e = *(const u32x4*)(E + off);
                    const f32x4 v0 = acc[ai][bj][m][0] * sc, v1 = acc[ai][bj][m][1] * sc; float o[8];
                    o[0] = bflo(e.x) * sigmoid_f(v0[0]); o[1] = bfhi(e.x) * sigmoid_f(v0[1]); o[2] = bflo(e.y) * sigmoid_f(v0[2]); o[3] = bfhi(e.y) * sigmoid_f(v0[3]);
                    o[4] = bflo(e.z) * sigmoid_f(v1[0]); o[5] = bfhi(e.z) * sigmoid_f(v1[1]); o[6] = bflo(e.w) * sigmoid_f(v1[2]); o[7] = bfhi(e.w) * sigmoid_f(v1[3]);
#pragma unroll
                    for (int k = 0; k < 8; ++k) ss += o[k] * o[k];
                    u32x4 w; w.x = pk2(o[0], o[1]); w.y = pk2(o[2], o[3]); w.z = pk2(o[4], o[5]); w.w = pk2(o[6], o[7]);
                    *(u32x4*)(Y + off) = w; }
                ss += __shfl_xor(ss, 16); ss += __shfl_xor(ss, 32);
                if (fq == 0) ssq[(size_t)row * 16 + (u.pn & 3) * 4 + wc] = ss; }
    }
};
template <class Epi, class Sched, bool ALIGN_EPI = false, bool SP2 = false>
__device__ __forceinline__ void gemm_phase(PG8_LAS unsigned char* lds, const Gemm g, const Sched& S, const Epi& E) {
    int tid_o = threadIdx.x; asm volatile("" : "+v"(tid_o));
    const int tid = tid_o, wid = __builtin_amdgcn_readfirstlane(tid >> 6), lane = tid & 63, wr = wid >> 2, wc = wid & 3, fr = lane & 15, fq = lane >> 4;
    const int K = g.K, nt = K / BK;
    unsigned voffA[2], voffB[2];
#pragma unroll
    for (int i = 0; i < 2; ++i) { int R, C; stage_rc(tid * 16 + i * 8192, R, C); const int Rb = Epi::PERM ? ((R & ~31) + perm32(R & 31)) : R;
        voffA[i] = (unsigned)(R * K + C) * 2u; voffB[i] = (unsigned)(Rb * K + C) * 2u; }
    const size_t kstep = (size_t)(BK * 2);
    const size_t hstep = (size_t)HALF * K * 2;
    const size_t tstep = 2 * hstep;
    const unsigned ldsw = (unsigned)wid * 1024u;
    const int aoff = lds_byte(wr * 64 + fr, fq * 8), boff = lds_byte(wc * 32 + fr, fq * 8);
#define PG8_SA(b, h) (((b) * 2 + (h)) * HTB)
#define PG8_SB(b, h) ((4 + (b) * 2 + (h)) * HTB)
#define PG8_STAGE(bufoff, gbase, voff) do { _Pragma("unroll") for (int _i = 0; _i < 2; ++_i) \
        __builtin_amdgcn_global_load_lds((const unsigned*)((const char*)(gbase) + (voff)[_i]), (PG8_LAS unsigned*)(lds + (bufoff) + ldsw + _i * 8192), 16, 0, 0); } while (0)
#define PG8_LDA(dst, b, h) do { _Pragma("unroll") for (int m = 0; m < 4; ++m) _Pragma("unroll") for (int k = 0; k < 2; ++k) dst[m][k] = *(const PG8_LAS bf16x8*)(lds + PG8_SA(b, h) + aoff + m * 2048 + k * 1024); } while (0)
#define PG8_LDB(dst, b, h) do { _Pragma("unroll") for (int n = 0; n < 2; ++n) _Pragma("unroll") for (int k = 0; k < 2; ++k) dst[n][k] = *(const PG8_LAS bf16x8*)(lds + PG8_SB(b, h) + boff + n * 2048 + k * 1024); } while (0)
#define PG8_MMA(ai, bj, At, Bt) do { __builtin_amdgcn_s_setprio(1); _Pragma("unroll") for (int m = 0; m < 4; ++m) _Pragma("unroll") for (int n = 0; n < 2; ++n) _Pragma("unroll") for (int k = 0; k < 2; ++k) \
        acc[ai][bj][m][n] = __builtin_amdgcn_mfma_f32_16x16x32_bf16(Bt[n][k], At[m][k], acc[ai][bj][m][n], 0, 0, 0); __builtin_amdgcn_s_setprio(0); } while (0)
#define PG8_WAIT_V(n) asm volatile("s_waitcnt vmcnt(" #n ")" ::: "memory")
#define PG8_WAIT_L(n) asm volatile("s_waitcnt lgkmcnt(" #n ")" ::: "memory")
#define PG8_BAR __builtin_amdgcn_s_barrier()
#define PG8_SCHED __builtin_amdgcn_sched_barrier(0)
    Unit cur, nxt; int ui = 0;
    if (!S.next(0, cur)) return;
    f32x4 acc[2][2][4][2];
#pragma unroll
    for (int a = 0; a < 2; ++a)
#pragma unroll
        for (int b = 0; b < 2; ++b)
#pragma unroll
            for (int m = 0; m < 4; ++m)
#pragma unroll
                for (int n = 0; n < 2; ++n) acc[a][b][m][n] = (f32x4){0.f, 0.f, 0.f, 0.f};
    bf16x8 At[4][2], B0[2][2], B1[2][2];
    const char* cA = (const char*)g.A + (size_t)cur.pm * tstep; const char* cB = (const char*)g.Bt + (size_t)cur.pn * tstep;
    S.a_ready(cur);
    if constexpr (SP2) {
        PG8_STAGE(PG8_SB(0, 0), cB, voffB); PG8_STAGE(PG8_SB(0, 1), cB + hstep, voffB); PG8_STAGE(PG8_SA(0, 0), cA, voffA); PG8_STAGE(PG8_SA(0, 1), cA + hstep, voffA);
        if (wr == 1) PG8_BAR;
        PG8_WAIT_V(2); PG8_BAR;
        PG8_STAGE(PG8_SB(1, 0), cB + kstep, voffB); PG8_STAGE(PG8_SA(1, 0), cA + kstep, voffA); PG8_STAGE(PG8_SB(1, 1), cB + hstep + kstep, voffB);
        PG8_WAIT_V(6); PG8_BAR;
    } else {
        PG8_STAGE(PG8_SB(0, 0), cB, voffB); PG8_STAGE(PG8_SA(0, 0), cA, voffA); PG8_STAGE(PG8_SB(0, 1), cB + hstep, voffB); PG8_STAGE(PG8_SA(0, 1), cA + hstep, voffA);
        if (wr == 1) PG8_BAR;
        PG8_WAIT_V(4); PG8_BAR;
        PG8_STAGE(PG8_SB(1, 0), cB + kstep, voffB); PG8_STAGE(PG8_SA(1, 0), cA + kstep, voffA); PG8_STAGE(PG8_SB(1, 1), cB + hstep + kstep, voffB);
        PG8_WAIT_V(6); PG8_BAR;
    }
    for (;;) {
        const bool has_next = S.next(ui + 1, nxt);
        const char* nA = has_next ? (const char*)g.A + (size_t)nxt.pm * tstep : cA; const char* nB = has_next ? (const char*)g.Bt + (size_t)nxt.pn * tstep : cB;
        for (int t = 0; t < nt; t += 2) {
            const bool last = (t == nt - 2);
            const char* a1 = cA + (size_t)(t + 1) * kstep;
            const char* a2 = last ? nA : cA + (size_t)(t + 2) * kstep; const char* b2 = last ? nB : cB + (size_t)(t + 2) * kstep;
            const char* a3 = a2 + kstep; const char* b3 = b2 + kstep;
            if (last && has_next) S.a_ready(nxt);
            if constexpr (SP2) {
            PG8_LDB(B0, 0, 0); PG8_LDB(B1, 0, 1); PG8_SCHED; PG8_LDA(At, 0, 0); PG8_STAGE(PG8_SA(1, 1), a1 + hstep, voffA);
            PG8_WAIT_V(8); PG8_WAIT_L(0); PG8_BAR; PG8_MMA(0, 0, At, B0); PG8_MMA(0, 1, At, B1); PG8_BAR; PG8_SCHED;
            PG8_LDA(At, 0, 1); PG8_STAGE(PG8_SB(0, 0), b2, voffB); PG8_STAGE(PG8_SB(0, 1), b2 + hstep, voffB); PG8_STAGE(PG8_SA(0, 0), a2, voffA);
            PG8_WAIT_V(8); PG8_WAIT_L(0); PG8_BAR; PG8_MMA(1, 0, At, B0); PG8_MMA(1, 1, At, B1); PG8_BAR; PG8_SCHED;
            PG8_LDB(B0, 1, 0); PG8_LDB(B1, 1, 1); PG8_SCHED; PG8_LDA(At, 1, 0); PG8_STAGE(PG8_SA(0, 1), a2 + hstep, voffA);
            PG8_WAIT_V(8); PG8_WAIT_L(0); PG8_BAR; PG8_MMA(0, 0, At, B0); PG8_MMA(0, 1, At, B1); PG8_BAR; PG8_SCHED;
            PG8_LDA(At, 1, 1); PG8_STAGE(PG8_SB(1, 0), b3, voffB); PG8_STAGE(PG8_SB(1, 1), b3 + hstep, voffB); PG8_STAGE(PG8_SA(1, 0), a3, voffA);
            PG8_WAIT_V(8); PG8_WAIT_L(0); PG8_BAR; PG8_MMA(1, 0, At, B0); PG8_MMA(1, 1, At, B1); PG8_BAR; PG8_SCHED;
            } else {
            PG8_LDB(B0, 0, 0); PG8_SCHED; PG8_LDA(At, 0, 0); PG8_STAGE(PG8_SA(1, 1), a1 + hstep, voffA);
            PG8_WAIT_L(8); PG8_BAR; PG8_WAIT_L(0); PG8_MMA(0, 0, At, B0); PG8_BAR; PG8_SCHED;
            PG8_LDB(B1, 0, 1); PG8_STAGE(PG8_SB(0, 0), b2, voffB);
            PG8_BAR; PG8_WAIT_L(0); PG8_MMA(0, 1, At, B1); PG8_BAR;
            PG8_LDA(At, 0, 1); PG8_STAGE(PG8_SA(0, 0), a2, voffA);
            PG8_BAR; PG8_WAIT_L(0); PG8_MMA(1, 0, At, B0); PG8_BAR; PG8_SCHED;
            PG8_STAGE(PG8_SB(0, 1), b2 + hstep, voffB);
            PG8_WAIT_V(6); PG8_BAR; PG8_MMA(1, 1, At, B1); PG8_BAR;
            PG8_LDB(B0, 1, 0); PG8_SCHED; PG8_LDA(At, 1, 0); PG8_STAGE(PG8_SA(0, 1), a2 + hstep, voffA);
            PG8_WAIT_L(8); PG8_BAR; PG8_WAIT_L(0); PG8_MMA(0, 0, At, B0); PG8_BAR; PG8_SCHED;
            PG8_LDB(B1, 1, 1); PG8_STAGE(PG8_SB(1, 0), b3, voffB);
            PG8_BAR; PG8_WAIT_L(0); PG8_MMA(0, 1, At, B1); PG8_BAR;
            PG8_LDA(At, 1, 1); PG8_STAGE(PG8_SA(1, 0), a3, voffA);
            PG8_BAR; PG8_WAIT_L(0); PG8_MMA(1, 0, At, B0); PG8_BAR; PG8_SCHED;
            PG8_STAGE(PG8_SB(1, 1), b3 + hstep, voffB);
            PG8_WAIT_V(6); PG8_BAR; PG8_MMA(1, 1, At, B1); PG8_BAR;
            }
        }
        if constexpr (ALIGN_EPI) { if (wr == 0) PG8_BAR; }
        if constexpr (!Epi::AFTER_DRAIN) { E(acc, cur, wr, wc, fr, fq); S.done(cur); }
        if (!has_next) break;
#pragma unroll
        for (int a = 0; a < 2; ++a)
#pragma unroll
            for (int b = 0; b < 2; ++b)
#pragma unroll
                for (int m = 0; m < 4; ++m)
#pragma unroll
                    for (int n = 0; n < 2; ++n) acc[a][b][m][n] = (f32x4){0.f, 0.f, 0.f, 0.f};
        cur = nxt; cA = nA; cB = nB; ++ui;
        if constexpr (ALIGN_EPI) { if (wr == 1) PG8_BAR; }
    }
    PG8_WAIT_V(0);
    if constexpr (!ALIGN_EPI) { if (wr == 0) PG8_BAR; }
    PG8_BAR;
    if constexpr (Epi::AFTER_DRAIN) { E.fused(acc, cur, wr, wc, fr, fq, lds, wid, lane); S.done(cur); }
#undef PG8_SA
#undef PG8_SB
#undef PG8_STAGE
#undef PG8_LDA
#undef PG8_LDB
#undef PG8_MMA
#undef PG8_WAIT_V
#undef PG8_WAIT_L
#undef PG8_BAR
#undef PG8_SCHED
}
}
#define DI __device__ __forceinline__
typedef unsigned short bf16;
typedef short bf16x8 __attribute__((ext_vector_type(8)));
typedef float f32x4 __attribute__((ext_vector_type(4)));
typedef float f32x16 __attribute__((ext_vector_type(16)));
typedef unsigned u32x4 __attribute__((ext_vector_type(4)));
typedef unsigned u32x2 __attribute__((ext_vector_type(2)));
using pg8::pk2; using pg8::bflo; using pg8::bfhi; using pg8::ZP;
#define MFMA32(a, b, c) __builtin_amdgcn_mfma_f32_32x32x16_bf16((a), (b), (c), 0, 0, 0)
constexpr int NB = 2, S = 16384, T = NB * S, DM = 1024, DEPTH = 2, DFF = 4096, NIN = 3206;
constexpr float EPS = 1e-6f, LOG2E = 1.4426950408889634f;
constexpr int NCH = S / 128;
enum { I_X = 0, I_P, I_POS, I_MIXPRE, I_WIN, I_SGUVG, I_SGUW, I_SGUB, I_FOXB, I_WO, I_MIXPOST, I_FFNPRE, I_WGATE, I_WUP, I_CONVW, I_CONVB, I_WDOWN, I_FFNPOST, I_PLEPRE, I_WPG, I_WPP, I_PLEPOST, N_INPUTS };
constexpr size_t MiB = 1u << 20;
constexpr size_t WS_CTL = 0;
constexpr size_t WS_RINVX = 1 * MiB;
constexpr size_t WS_SSQY = WS_RINVX + 128 * 1024;
constexpr size_t WS_CT = WS_SSQY + 128 * 1024;
constexpr size_t WS_LF = 2 * MiB;
constexpr size_t WS_CL = 3 * MiB;
constexpr size_t WS_C2 = 4 * MiB;
constexpr size_t WS_COS = 5 * MiB;
constexpr size_t WS_SIN = 9 * MiB;
constexpr size_t WS_SSQP = 13 * MiB;
constexpr size_t WS_W = 16 * MiB;
constexpr size_t W_IN = 0, W_O = W_IN + (size_t)ZP * 1024 * 2, W_G = W_O + 2 * MiB, W_U = W_G + 8 * MiB, W_D = W_U + 8 * MiB, W_PG = W_D + 8 * MiB, W_PP = W_PG + 2 * MiB;
constexpr size_t WS_PB = 52 * MiB;
constexpr size_t WS_XB = 68 * MiB;
constexpr size_t WS_RB = 132 * MiB;
constexpr size_t WS_RA = 232 * MiB;
constexpr size_t WS_END = 488 * MiB;
static_assert(W_PP + 512 * 1024 <= 36 * MiB, "weights");

struct Params { const float* in[N_INPUTS]; float* out; unsigned char* ws; float lg2gam[6]; int pad[2]; };

DI float wave_sum(float v) {
#pragma unroll
    for (int o = 1; o < 64; o <<= 1) v += __shfl_xor(v, o);
    return v;
}
DI int crow(int reg, int h) { return (reg & 3) + 8 * (reg >> 2) + 4 * h; }
DI unsigned short f2bf(float f) { return (unsigned short)(pk2(f, 0.f) & 0xffffu); }
DI float bf2f(unsigned short h) { return __uint_as_float((unsigned)h << 16); }
DI bf16x8 pack8(const f32x16& x, int s8) { u32x4 p; p.x = pk2(x[s8], x[s8 + 1]); p.y = pk2(x[s8 + 2], x[s8 + 3]); p.z = pk2(x[s8 + 4], x[s8 + 5]); p.w = pk2(x[s8 + 6], x[s8 + 7]); return __builtin_bit_cast(bf16x8, p); }

DI void transpose_item(const float* W, const float* g, int K, int N, int nblk, bf16* WT, float* scr, int item, int lane) {
    const int kb = item / nblk, nb = item % nblk, k0 = 64 * kb, n0 = 32 * nb;
    const int n = n0 + (lane & 31); const bool ok = n < N;
#pragma unroll 8
    for (int i = 0; i < 32; ++i) { const int kk = 2 * i + (lane >> 5); float v = ok ? W[(size_t)(k0 + kk) * N + n] : 0.f; if (g) v *= g[k0 + kk]; scr[kk * 33 + (lane & 31)] = v; }
    asm volatile("s_waitcnt lgkmcnt(0)" ::: "memory");
    const int c = lane & 7;
#pragma unroll
    for (int j = 0; j < 4; ++j) { const int nn = (lane >> 3) + 8 * j; const float* s = scr + (8 * c) * 33 + nn;
        u32x4 o; o.x = pk2(s[0 * 33], s[1 * 33]); o.y = pk2(s[2 * 33], s[3 * 33]); o.z = pk2(s[4 * 33], s[5 * 33]); o.w = pk2(s[6 * 33], s[7 * 33]);
        *(u32x4*)(WT + (size_t)(n0 + nn) * K + k0 + 8 * c) = o; }
    asm volatile("s_waitcnt lgkmcnt(0)" ::: "memory");
}
DI void convert_weights(const Params& P, int layer, char* lds, int gw, int NGW, int wave, int lane) {
    float* scr = (float*)(lds + wave * 16384);
    unsigned char* wb = P.ws + WS_W;
    constexpr int I_IN = 16 * 104, I_O = 16 * 32, I_G = 16 * 128, I_D = 64 * 32, I_PG = 16 * 32, I_PP = 4 * 32;
    constexpr int NITEMS = I_IN + I_O + 2 * I_G + I_D + I_PG + I_PP;
    for (int it = gw; it < NITEMS; it += NGW) {
        int r = it;
        if (r < I_IN) { transpose_item(P.in[I_WIN] + (size_t)layer * 1024 * NIN, P.in[I_MIXPRE] + layer * 1024, 1024, NIN, 104, (bf16*)(wb + W_IN), scr, r, lane); continue; } r -= I_IN;
        if (r < I_O) { transpose_item(P.in[I_WO] + (size_t)layer * 1024 * 1024, nullptr, 1024, 1024, 32, (bf16*)(wb + W_O), scr, r, lane); continue; } r -= I_O;
        if (r < I_G) { transpose_item(P.in[I_WGATE] + (size_t)layer * 1024 * DFF, P.in[I_FFNPRE] + layer * 1024, 1024, DFF, 128, (bf16*)(wb + W_G), scr, r, lane); continue; } r -= I_G;
        if (r < I_G) { transpose_item(P.in[I_WUP] + (size_t)layer * 1024 * DFF, P.in[I_FFNPRE] + layer * 1024, 1024, DFF, 128, (bf16*)(wb + W_U), scr, r, lane); continue; } r -= I_G;
        if (r < I_D) { transpose_item(P.in[I_WDOWN] + (size_t)layer * DFF * 1024, nullptr, DFF, 1024, 32, (bf16*)(wb + W_D), scr, r, lane); continue; } r -= I_D;
        if (r < I_PG) { transpose_item(P.in[I_WPG] + (size_t)layer * 1024 * 1024, P.in[I_PLEPRE] + layer * 1024, 1024, 1024, 32, (bf16*)(wb + W_PG), scr, r, lane); continue; } r -= I_PG;
        transpose_item(P.in[I_WPP] + (size_t)layer * 256 * 1024, nullptr, 256, 1024, 32, (bf16*)(wb + W_PP), scr, r, lane);
    }
    const float* pp = P.in[I_P] + (size_t)layer * T * 256; bf16* pb = (bf16*)(P.ws + WS_PB);
    for (size_t i = (size_t)gw * 64 + lane; i < (size_t)T * 256 / 8; i += (size_t)NGW * 64) {
        const f32x4 a = *(const f32x4*)(pp + i * 8), b = *(const f32x4*)(pp + i * 8 + 4);
        u32x4 o; o.x = pk2(a[0], a[1]); o.y = pk2(a[2], a[3]); o.z = pk2(b[0], b[1]); o.w = pk2(b[2], b[3]);
        *(u32x4*)(pb + i * 8) = o; }
}
DI void resid_rows(const Params& P, const float* xsrc, float* xdst, const bf16* Y, const float* gain, int gw, int NGW, int lane) {
    const float* ssqp = (const float*)(P.ws + WS_SSQP); float* rinvx = (float*)(P.ws + WS_RINVX); bf16* XB = (bf16*)(P.ws + WS_XB);
    for (int row = gw; row < T; row += NGW) {
        const size_t off = (size_t)row * 1024 + lane * 8;
        float v[16];
#pragma unroll
        for (int j = 0; j < 2; ++j) { const f32x4 a = *(const f32x4*)(xsrc + off + j * 512), b = *(const f32x4*)(xsrc + off + j * 512 + 4);
            v[8 * j + 0] = a[0]; v[8 * j + 1] = a[1]; v[8 * j + 2] = a[2]; v[8 * j + 3] = a[3]; v[8 * j + 4] = b[0]; v[8 * j + 5] = b[1]; v[8 * j + 6] = b[2]; v[8 * j + 7] = b[3]; }
        if (Y) { float sp = lane < 16 ? ssqp[(size_t)row * 16 + lane] : 0.f; sp = wave_sum(sp); const float ry = rsqrtf(sp * (1.0f / 1024.0f) + EPS);
#pragma unroll
            for (int j = 0; j < 2; ++j) { const u32x4 y = *(const u32x4*)(Y + off + j * 512); const f32x4 g0 = *(const f32x4*)(gain + lane * 8 + j * 512), g1 = *(const f32x4*)(gain + lane * 8 + j * 512 + 4);
                v[8 * j + 0] += bflo(y.x) * ry * g0[0]; v[8 * j + 1] += bfhi(y.x) * ry * g0[1]; v[8 * j + 2] += bflo(y.y) * ry * g0[2]; v[8 * j + 3] += bfhi(y.y) * ry * g0[3];
                v[8 * j + 4] += bflo(y.z) * ry * g1[0]; v[8 * j + 5] += bfhi(y.z) * ry * g1[1]; v[8 * j + 6] += bflo(y.w) * ry * g1[2]; v[8 * j + 7] += bfhi(y.w) * ry * g1[3]; }
        }
        float ss = 0.f;
#pragma unroll
        for (int k = 0; k < 16; ++k) ss += v[k] * v[k];
        ss = wave_sum(ss);
#pragma unroll
        for (int j = 0; j < 2; ++j) {
            if (xdst) { *(f32x4*)(xdst + off + j * 512) = (f32x4){v[8 * j], v[8 * j + 1], v[8 * j + 2], v[8 * j + 3]}; *(f32x4*)(xdst + off + j * 512 + 4) = (f32x4){v[8 * j + 4], v[8 * j + 5], v[8 * j + 6], v[8 * j + 7]}; }
            u32x4 o; o.x = pk2(v[8 * j], v[8 * j + 1]); o.y = pk2(v[8 * j + 2], v[8 * j + 3]); o.z = pk2(v[8 * j + 4], v[8 * j + 5]); o.w = pk2(v[8 * j + 6], v[8 * j + 7]);
            *(u32x4*)(XB + off + j * 512) = o; }
        if (lane == 0) rinvx[row] = rsqrtf(ss * (1.0f / 1024.0f) + EPS);
    }
}
DI void rope_table(const Params& P, int gtid, int NT) {
    const int* pos = (const int*)P.in[I_POS]; float* C = (float*)(P.ws + WS_COS); float* Sn = (float*)(P.ws + WS_SIN);
    for (int i = gtid; i < T * 32; i += NT) { const int row = i >> 5, j = i & 31;
        const double invf = exp2(-(double)j * (13.287712379549449 / 32.0));
        const double ang = (double)pos[row] * invf;
        const double q = rint(ang * 0.6366197723675814); const double y = fma(-q, 1.5707963267948966, ang) - q * 6.123233995736766e-17;
        const double y2 = y * y;
        const double sp = y * (1.0 + y2 * (-1.0 / 6 + y2 * (1.0 / 120 + y2 * (-1.0 / 5040 + y2 * (1.0 / 362880 + y2 * (-1.0 / 39916800))))));
        const double cp = 1.0 + y2 * (-0.5 + y2 * (1.0 / 24 + y2 * (-1.0 / 720 + y2 * (1.0 / 40320 + y2 * (-1.0 / 3628800 + y2 * (1.0 / 479001600))))));
        const int qi = (int)((long long)q & 3);
        const double sv = (qi == 0) ? sp : (qi == 1) ? cp : (qi == 2) ? -sp : -cp;
        const double cv = (qi == 0) ? cp : (qi == 1) ? -sp : (qi == 2) ? -cp : sp;
        C[i] = (float)cv; Sn[i] = (float)sv; }
}
constexpr int ST72 = 72, ST136 = 136, ST68 = 68;
DI void sgu_unit(const Params& P, int layer, int b, int c, int hh, char* lds) {
    int tid_u = threadIdx.x; asm volatile("" : "+v"(tid_u)); const int tid = tid_u, lane = tid & 63, wid = tid >> 6, r = lane & 31, h = lane >> 5;
    bf16* Wt = (bf16*)lds; bf16* VT = Wt + 128 * ST136;
    const bf16* Z = (const bf16*)(P.ws + WS_RA); bf16* MIX = (bf16*)(P.ws + WS_RB);
    const float* W = P.in[I_SGUW] + (size_t)(layer * 4 + hh) * 128 * 128;
#pragma unroll
    for (int j = 0; j < 8; ++j) { const int idx = (j * 512 + tid) * 4, t = idx >> 7, s = idx & 127; const f32x4 w = *(const f32x4*)(W + idx);
        u32x2 o; o.x = pk2(s <= t ? w[0] : 0.f, s + 1 <= t ? w[1] : 0.f); o.y = pk2(s + 2 <= t ? w[2] : 0.f, s + 3 <= t ? w[3] : 0.f);
        *(u32x2*)(Wt + t * ST136 + s) = o; }
    const size_t row0 = (size_t)b * S + (size_t)c * 128;
    { const int s = tid >> 2, dq = tid & 3; const bf16* vp = Z + (row0 + s) * ZP + 256 + hh * 64 + dq * 16;
      const u32x4 a = *(const u32x4*)vp, bb = *(const u32x4*)(vp + 8); float v[16];
      v[0] = bflo(a.x); v[1] = bfhi(a.x); v[2] = bflo(a.y); v[3] = bfhi(a.y); v[4] = bflo(a.z); v[5] = bfhi(a.z); v[6] = bflo(a.w); v[7] = bfhi(a.w);
      v[8] = bflo(bb.x); v[9] = bfhi(bb.x); v[10] = bflo(bb.y); v[11] = bfhi(bb.y); v[12] = bflo(bb.z); v[13] = bfhi(bb.z); v[14] = bflo(bb.w); v[15] = bfhi(bb.w);
      float ss = 0.f;
#pragma unroll
      for (int i = 0; i < 16; ++i) ss += v[i] * v[i];
      ss += __shfl_xor(ss, 1); ss += __shfl_xor(ss, 2);
      const float rn = rsqrtf(ss * (1.0f / 64.0f) + EPS); const float* g = P.in[I_SGUVG] + (layer * 4 + hh) * 64 + dq * 16;
#pragma unroll
      for (int i = 0; i < 16; ++i) VT[(dq * 16 + i) * ST136 + s] = f2bf(v[i] * rn * g[i]); }
    __syncthreads();
    const int tb = wid >> 1, db = wid & 1; f32x16 acc = {};
    for (int ks = 0; ks < 2 * (tb + 1); ++ks) { const bf16x8 a = *(const bf16x8*)(Wt + (32 * tb + r) * ST136 + 16 * ks + 8 * h); const bf16x8 bb = *(const bf16x8*)(VT + (32 * db + r) * ST136 + 16 * ks + 8 * h); acc = MFMA32(a, bb, acc); }
    const float* bs = P.in[I_SGUB] + (layer * 4 + hh) * 128;
#pragma unroll
    for (int i = 0; i < 16; ++i) { const int t = 32 * tb + crow(i, h), d = 32 * db + r; const float uu = bf2f(Z[(row0 + t) * ZP + hh * 64 + d]);
        MIX[(row0 + t) * 1024 + hh * 64 + d] = f2bf(uu * (acc[i] + bs[t])); }
    __syncthreads();
}
DI void load_rot(const bf16* zh, const float* cs, const float* sn, int dq, float scale, float (&o1)[8], float (&o2)[8]) {
    const u32x4 a = *(const u32x4*)(zh + dq * 8), bb = *(const u32x4*)(zh + 32 + dq * 8);
    const f32x4 c0 = *(const f32x4*)(cs + dq * 8), c1 = *(const f32x4*)(cs + dq * 8 + 4), s0 = *(const f32x4*)(sn + dq * 8), s1 = *(const f32x4*)(sn + dq * 8 + 4);
    float x1[8] = {bflo(a.x), bfhi(a.x), bflo(a.y), bfhi(a.y), bflo(a.z), bfhi(a.z), bflo(a.w), bfhi(a.w)};
    float x2[8] = {bflo(bb.x), bfhi(bb.x), bflo(bb.y), bfhi(bb.y), bflo(bb.z), bfhi(bb.z), bflo(bb.w), bfhi(bb.w)};
#pragma unroll
    for (int j = 0; j < 8; ++j) { const float cc = j < 4 ? c0[j & 3] : c1[j & 3], sv = j < 4 ? s0[j & 3] : s1[j & 3];
        o1[j] = (x1[j] * cc - x2[j] * sv) * scale; o2[j] = (x1[j] * sv + x2[j] * cc) * scale; }
}
DI void ret1_unit(const Params& P, float lg, int b, int hh, int c, char* lds) {
    int tid_u = threadIdx.x; asm volatile("" : "+v"(tid_u)); const int tid = tid_u, lane = tid & 63, wid = tid >> 6, r = lane & 31, h = lane >> 5;
    bf16* KT = (bf16*)lds; bf16* VT = KT + 64 * ST136;
    const bf16* Z = (const bf16*)(P.ws + WS_RA); float* ST = (float*)(P.ws + WS_RB + 64 * MiB);
    const size_t row0 = (size_t)b * S + (size_t)c * 128;
    { const int s = tid >> 2, dq = tid & 3; const size_t row = row0 + s; float o1[8], o2[8];
      load_rot(Z + row * ZP + 896 + hh * 64, (const float*)(P.ws + WS_COS) + row * 32, (const float*)(P.ws + WS_SIN) + row * 32, dq, 0.125f * __builtin_amdgcn_exp2f((float)(127 - s) * lg), o1, o2);
#pragma unroll
      for (int j = 0; j < 8; ++j) { KT[(dq * 8 + j) * ST136 + s] = f2bf(o1[j]); KT[(32 + dq * 8 + j) * ST136 + s] = f2bf(o2[j]); }
      const bf16* vp = Z + row * ZP + 1280 + hh * 64 + dq * 16; const u32x4 a = *(const u32x4*)vp, bb = *(const u32x4*)(vp + 8);
      const unsigned vv[8] = {a.x, a.y, a.z, a.w, bb.x, bb.y, bb.z, bb.w};
#pragma unroll
      for (int i = 0; i < 8; ++i) { VT[(dq * 16 + 2 * i) * ST136 + s] = (bf16)(vv[i] & 0xffffu); VT[(dq * 16 + 2 * i + 1) * ST136 + s] = (bf16)(vv[i] >> 16); } }
    __syncthreads();
    if (wid < 4) { const int db = wid >> 1, eb = wid & 1; f32x16 acc = {};
#pragma unroll
        for (int ks = 0; ks < 8; ++ks) { const bf16x8 a = *(const bf16x8*)(KT + (32 * db + r) * ST136 + 16 * ks + 8 * h); const bf16x8 bb = *(const bf16x8*)(VT + (32 * eb + r) * ST136 + 16 * ks + 8 * h); acc = MFMA32(a, bb, acc); }
        float* st = ST + ((size_t)((b * 6 + hh) * NCH + c)) * 4096;
#pragma unroll
        for (int i = 0; i < 16; ++i) st[(32 * db + crow(i, h)) * 64 + 32 * eb + r] = acc[i]; }
    __syncthreads();
}
DI void cum_unit(const Params& P, int b, int c) {
    int tid_u = threadIdx.x; asm volatile("" : "+v"(tid_u)); const int tid = tid_u, lane = tid & 63, wid = tid >> 6;
    if (wid < 6) { const float* LF = (const float*)(P.ws + WS_LF); float* CL = (float*)(P.ws + WS_CL); float* CT = (float*)(P.ws + WS_CT);
        const size_t row = (size_t)b * S + (size_t)c * 128 + 2 * lane; const float v0 = LF[row * 8 + wid], v1 = LF[(row + 1) * 8 + wid];
        float x = v0 + v1;
#pragma unroll
        for (int o = 1; o < 64; o <<= 1) { const float y = __shfl_up(x, o); if (lane >= o) x += y; }
        float* cl = CL + (size_t)(b * 6 + wid) * S + (size_t)c * 128 + 2 * lane; cl[0] = x - v1; cl[1] = x;
        if (lane == 63) CT[(b * 6 + wid) * NCH + c] = x; }
}
DI void ret3_unit(const Params& P, float lg, int b, int hh, int c, char* lds) {
    int tid_u = threadIdx.x; asm volatile("" : "+v"(tid_u)); const int tid = tid_u, lane = tid & 63, wid = tid >> 6, r = lane & 31, h = lane >> 5;
    bf16* Q = (bf16*)lds; bf16* K = Q + 128 * ST72; bf16* VT = K + 128 * ST72; bf16* RT = VT + 64 * ST136; bf16* Pm = RT + 64 * ST72; float* O = (float*)lds;
    const bf16* Z = (const bf16*)(P.ws + WS_RA); bf16* MIX = (bf16*)(P.ws + WS_RB); const float* ST = (const float*)(P.ws + WS_RB + 64 * MiB) + ((size_t)((b * 6 + hh) * NCH + c)) * 4096;
    const size_t row0 = (size_t)b * S + (size_t)c * 128;
    { const int s = tid >> 2, dq = tid & 3; const size_t row = row0 + s; float o1[8], o2[8];
      const float* cs = (const float*)(P.ws + WS_COS) + row * 32; const float* sn = (const float*)(P.ws + WS_SIN) + row * 32;
      load_rot(Z + row * ZP + 512 + hh * 64, cs, sn, dq, 1.0f, o1, o2);
      { u32x4 w; w.x = pk2(o1[0], o1[1]); w.y = pk2(o1[2], o1[3]); w.z = pk2(o1[4], o1[5]); w.w = pk2(o1[6], o1[7]); *(u32x4*)(Q + s * ST72 + dq * 8) = w;
        w.x = pk2(o2[0], o2[1]); w.y = pk2(o2[2], o2[3]); w.z = pk2(o2[4], o2[5]); w.w = pk2(o2[6], o2[7]); *(u32x4*)(Q + s * ST72 + 32 + dq * 8) = w; }
      load_rot(Z + row * ZP + 896 + hh * 64, cs, sn, dq, 0.125f, o1, o2);
      { u32x4 w; w.x = pk2(o1[0], o1[1]); w.y = pk2(o1[2], o1[3]); w.z = pk2(o1[4], o1[5]); w.w = pk2(o1[6], o1[7]); *(u32x4*)(K + s * ST72 + dq * 8) = w;
        w.x = pk2(o2[0], o2[1]); w.y = pk2(o2[2], o2[3]); w.z = pk2(o2[4], o2[5]); w.w = pk2(o2[6], o2[7]); *(u32x4*)(K + s * ST72 + 32 + dq * 8) = w; }
      const bf16* vp = Z + row * ZP + 1280 + hh * 64 + dq * 16; const u32x4 a = *(const u32x4*)vp, bb = *(const u32x4*)(vp + 8);
      const unsigned vv[8] = {a.x, a.y, a.z, a.w, bb.x, bb.y, bb.z, bb.w};
#pragma unroll
      for (int i = 0; i < 8; ++i) { VT[(dq * 16 + 2 * i) * ST136 + s] = (bf16)(vv[i] & 0xffffu); VT[(dq * 16 + 2 * i + 1) * ST136 + s] = (bf16)(vv[i] >> 16); }
      const int d = tid >> 3, e0 = (tid & 7) * 8; const f32x4 r0 = *(const f32x4*)(ST + d * 64 + e0), r1 = *(const f32x4*)(ST + d * 64 + e0 + 4);
#pragma unroll
      for (int i = 0; i < 4; ++i) { RT[(e0 + i) * ST72 + d] = f2bf(r0[i]); RT[(e0 + 4 + i) * ST72 + d] = f2bf(r1[i]); } }
    __syncthreads();
    for (int blk = wid; blk < 10; blk += 8) {
        const int tb = blk < 1 ? 0 : blk < 3 ? 1 : blk < 6 ? 2 : 3, sb = blk - (tb * (tb + 1)) / 2; f32x16 acc = {};
#pragma unroll
        for (int ks = 0; ks < 4; ++ks) { const bf16x8 a = *(const bf16x8*)(Q + (32 * tb + r) * ST72 + 16 * ks + 8 * h); const bf16x8 bb = *(const bf16x8*)(K + (32 * sb + r) * ST72 + 16 * ks + 8 * h); acc = MFMA32(a, bb, acc); }
#pragma unroll
        for (int i = 0; i < 16; ++i) { const int t = 32 * tb + crow(i, h), s = 32 * sb + r; const float v = s <= t ? acc[i] * __builtin_amdgcn_exp2f((float)(t - s) * lg) : 0.f; Pm[t * ST136 + s] = f2bf(v); }
    }
    __syncthreads();
    const int tb = wid >> 1, eb = wid & 1; f32x16 a1 = {}, a2 = {};
    for (int ks = 0; ks < 2 * (tb + 1); ++ks) { const bf16x8 a = *(const bf16x8*)(Pm + (32 * tb + r) * ST136 + 16 * ks + 8 * h); const bf16x8 bb = *(const bf16x8*)(VT + (32 * eb + r) * ST136 + 16 * ks + 8 * h); a1 = MFMA32(a, bb, a1); }
#pragma unroll
    for (int ks = 0; ks < 4; ++ks) { const bf16x8 a = *(const bf16x8*)(Q + (32 * tb + r) * ST72 + 16 * ks + 8 * h); const bf16x8 bb = *(const bf16x8*)(RT + (32 * eb + r) * ST72 + 16 * ks + 8 * h); a2 = MFMA32(a, bb, a2); }
    __syncthreads();
#pragma unroll
    for (int i = 0; i < 16; ++i) { const int t = 32 * tb + crow(i, h); O[t * 65 + 32 * eb + r] = a1[i] + a2[i] * __builtin_amdgcn_exp2f((float)(t + 1) * lg); }
    __syncthreads();
    { const int t = tid >> 2, eq = tid & 3; float v[16]; float ss = 0.f;
#pragma unroll
      for (int i = 0; i < 16; ++i) { v[i] = O[t * 65 + eq * 16 + i]; ss += v[i] * v[i]; }
      ss += __shfl_xor(ss, 1); ss += __shfl_xor(ss, 2);
      const float rn = rsqrtf(ss * (1.0f / 64.0f) + EPS); const size_t row = row0 + t;
      const bf16* gp = Z + row * ZP + 1664 + hh * 64 + eq * 16; const u32x4 ga = *(const u32x4*)gp, gb = *(const u32x4*)(gp + 8);
      const unsigned gg[8] = {ga.x, ga.y, ga.z, ga.w, gb.x, gb.y, gb.z, gb.w}; unsigned ow[8];
#pragma unroll
      for (int i = 0; i < 8; ++i) { const float g0 = bflo(gg[i]), g1 = bfhi(gg[i]);
          ow[i] = pk2(g0 * pg8::sigmoid_f(g0) * v[2 * i] * rn, g1 * pg8::sigmoid_f(g1) * v[2 * i + 1] * rn); }
      bf16* op = MIX + row * 1024 + 256 + hh * 64 + eq * 16;
      *(u32x4*)op = (u32x4){ow[0], ow[1], ow[2], ow[3]}; *(u32x4*)(op + 8) = (u32x4){ow[4], ow[5], ow[6], ow[7]}; }
    __syncthreads();
}
DI void fox_unit(const Params& P, int b, int hh, int qb, char* lds) {
    int tid_u = threadIdx.x; asm volatile("" : "+v"(tid_u)); const int tid = tid_u, lane = tid & 63, wid = tid >> 6, r = lane & 31, h = lane >> 5;
    bf16* Kt = (bf16*)lds; bf16* VT = Kt + 2 * 64 * ST72; float* NC = (float*)(VT + 2 * 64 * ST68);
    const bf16* Z = (const bf16*)(P.ws + WS_RA); bf16* MIX = (bf16*)(P.ws + WS_RB);
    const size_t rowb = (size_t)b * S; const int q0 = qb * 256;
    const float* c2 = (const float*)(P.ws + WS_C2) + (size_t)(b * 6 + hh) * S; const float cref = c2[q0];
    const int qrow = q0 + 32 * wid + r;
    bf16x8 qf[4];
    { const bf16* qp = Z + (rowb + qrow) * ZP + 2048 + hh * 64; const float sc = 0.125f * LOG2E;
#pragma unroll
      for (int s = 0; s < 4; ++s) { const u32x4 w = *(const u32x4*)(qp + 16 * s + 8 * h); u32x4 o;
          o.x = pk2(bflo(w.x) * sc, bfhi(w.x) * sc); o.y = pk2(bflo(w.y) * sc, bfhi(w.y) * sc); o.z = pk2(bflo(w.z) * sc, bfhi(w.z) * sc); o.w = pk2(bflo(w.w) * sc, bfhi(w.w) * sc);
          qf[s] = __builtin_bit_cast(bf16x8, o); } }
    f32x16 o0 = {}, o1 = {}; float m = -INFINITY, l = 0.f;
    const int ntile = 4 * (qb + 1);
    const int lrow = tid >> 3, lch = tid & 7;
    const bf16* kg = Z + (rowb + lrow) * ZP + 2432 + hh * 64 + lch * 8; const bf16* vg = Z + (rowb + lrow) * ZP + 2816 + hh * 64 + lch * 8;
    u32x4 kreg, vreg; float ncreg = 0.f;
#define FOX_LOAD(t) do { kreg = *(const u32x4*)(kg + (size_t)(t) * 64 * ZP); vreg = *(const u32x4*)(vg + (size_t)(t) * 64 * ZP); if (tid < 64) ncreg = cref - c2[64 * (t) + tid]; } while (0)
#define FOX_STORE(bufi) do { *(u32x4*)(Kt + (bufi) * 64 * ST72 + lrow * ST72 + lch * 8) = kreg; bf16* vt_ = VT + (bufi) * 64 * ST68 + (lch * 8) * ST68 + lrow; \
        vt_[0] = (bf16)(vreg.x & 0xffffu); vt_[ST68] = (bf16)(vreg.x >> 16); vt_[2 * ST68] = (bf16)(vreg.y & 0xffffu); vt_[3 * ST68] = (bf16)(vreg.y >> 16); \
        vt_[4 * ST68] = (bf16)(vreg.z & 0xffffu); vt_[5 * ST68] = (bf16)(vreg.z >> 16); vt_[6 * ST68] = (bf16)(vreg.w & 0xffffu); vt_[7 * ST68] = (bf16)(vreg.w >> 16); \
        if (tid < 64) NC[(bufi) * 64 + tid] = ncreg; } while (0)
    FOX_LOAD(ntile - 1); FOX_STORE(0); __syncthreads();
    int buf = 0;
    for (int t = ntile - 1; t >= 0; --t) {
        if (t > 0) FOX_LOAD(t - 1);
        const int kv0 = 64 * t;
        if (kv0 <= q0 + 32 * wid + 31) {
            const bf16* Kb = Kt + buf * 64 * ST72; const bf16* Vb = VT + buf * 64 * ST68; const float* NCb = NC + buf * 64;
            f32x16 p0 = {}, p1 = {};
#pragma unroll
            for (int s = 0; s < 4; ++s) { const bf16x8 a0 = *(const bf16x8*)(Kb + r * ST72 + 16 * s + 8 * h), a1 = *(const bf16x8*)(Kb + (32 + r) * ST72 + 16 * s + 8 * h);
                p0 = MFMA32(a0, qf[s], p0); p1 = MFMA32(a1, qf[s], p1); }
#pragma unroll
            for (int g = 0; g < 4; ++g) { const f32x4 n0 = *(const f32x4*)(NCb + 8 * g + 4 * h), n1 = *(const f32x4*)(NCb + 32 + 8 * g + 4 * h);
#pragma unroll
                for (int j = 0; j < 4; ++j) { p0[4 * g + j] += n0[j]; p1[4 * g + j] += n1[j]; } }
            if (kv0 + 63 > q0 + 32 * wid) {
#pragma unroll
                for (int i = 0; i < 16; ++i) { const int kv = kv0 + crow(i, h); if (kv > qrow) p0[i] = -INFINITY; if (kv + 32 > qrow) p1[i] = -INFINITY; } }
            float mx = fmaxf(p0[0], p1[0]);
#pragma unroll
            for (int i = 1; i < 16; ++i) mx = fmaxf(mx, fmaxf(p0[i], p1[i]));
            mx = fmaxf(mx, __shfl_xor(mx, 32));
            const float mn = fmaxf(m, mx), mu = (mn == -INFINITY) ? 0.f : mn; const float alpha = __builtin_amdgcn_exp2f(m - mu); m = mn;
            float ls = 0.f;
#pragma unroll
            for (int i = 0; i < 16; ++i) { p0[i] = __builtin_amdgcn_exp2f(p0[i] - mu); p1[i] = __builtin_amdgcn_exp2f(p1[i] - mu); ls += p0[i] + p1[i]; }
            l = l * alpha + ls;
#pragma unroll
            for (int i = 0; i < 16; ++i) { o0[i] *= alpha; o1[i] *= alpha; }
#pragma unroll
            for (int blk = 0; blk < 2; ++blk)
#pragma unroll
                for (int s = 0; s < 2; ++s) { const bf16x8 pf = blk == 0 ? pack8(p0, 8 * s) : pack8(p1, 8 * s); const int kvo = 32 * blk + 16 * s + 4 * h;
                    const u32x2 l0 = *(const u32x2*)(Vb + r * ST68 + kvo), h0 = *(const u32x2*)(Vb + r * ST68 + kvo + 8);
                    const u32x2 l1 = *(const u32x2*)(Vb + (32 + r) * ST68 + kvo), h1 = *(const u32x2*)(Vb + (32 + r) * ST68 + kvo + 8);
                    const u32x4 v0 = {l0.x, l0.y, h0.x, h0.y}, v1 = {l1.x, l1.y, h1.x, h1.y};
                    o0 = MFMA32(__builtin_bit_cast(bf16x8, v0), pf, o0); o1 = MFMA32(__builtin_bit_cast(bf16x8, v1), pf, o1); }
        }
        if (t > 0) FOX_STORE(buf ^ 1);
        __syncthreads();
        buf ^= 1;
    }
#undef FOX_LOAD
#undef FOX_STORE
    l += __shfl_xor(l, 32); const float inv = 1.0f / l;
    bf16* op = MIX + (rowb + qrow) * 1024 + 640 + hh * 64;
#pragma unroll
    for (int g = 0; g < 4; ++g) { u32x2 w; w.x = pk2(o0[4 * g] * inv, o0[4 * g + 1] * inv); w.y = pk2(o0[4 * g + 2] * inv, o0[4 * g + 3] * inv); *(u32x2*)(op + 8 * g + 4 * h) = w;
        w.x = pk2(o1[4 * g] * inv, o1[4 * g + 1] * inv); w.y = pk2(o1[4 * g + 2] * inv, o1[4 * g + 3] * inv); *(u32x2*)(op + 32 + 8 * g + 4 * h) = w; }
}
#ifndef PMASK
#define PMASK 0xffff
#endif
#define PEN(k) ((PMASK >> (k)) & 1)
constexpr int LDS_BYTES = 147456;
constexpr int LDS_QW = 140 * 1024;
typedef const __attribute__((address_space(4))) Params* kparams_t;
#if defined(__HIP_DEVICE_COMPILE__)
#define PH_COPY const Params P = *pp_;
#else
#define PH_COPY const Params P = Pk; const Params* pp_h = &Pk; (void)pp_h;
#endif
#define PH_BEGIN  kparams_t pp_ = (kparams_t)__builtin_amdgcn_kernarg_segment_ptr(); asm volatile("" : "+s"(pp_)); PH_COPY \
    int tid_ = threadIdx.x; asm volatile("" : "+v"(tid_)); const int tid = tid_, lane = tid & 63, wave = __builtin_amdgcn_readfirstlane(tid >> 6); \
    const int G = gridDim.x, bx = blockIdx.x, gw = bx * 8 + wave, NGW = G * 8; unsigned char* ws = P.ws; (void)lane; (void)gw; (void)NGW; (void)ws; \
    PG8_LAS unsigned char* L = (PG8_LAS unsigned char*)lds; (void)L;
#define GRID_SYNC() do { asm volatile("s_waitcnt vmcnt(0) lgkmcnt(0)" ::: "memory"); grid.sync(); __builtin_amdgcn_fence(__ATOMIC_ACQUIRE, "agent"); asm volatile("s_waitcnt vmcnt(0)" ::: "memory"); } while (0)
#define WSP(T_, off) ((T_*)(ws + (off)))
__global__ void __launch_bounds__(512, 2) fwd_kernel(Params Pk) {
    extern __shared__ __attribute__((aligned(16))) unsigned char lds[];
    cg::grid_group grid = cg::this_grid();
    { PH_BEGIN
      convert_weights(P, 0, (char*)lds, gw, NGW, wave, lane);
      rope_table(P, bx * 512 + tid, G * 512);
      resid_rows(P, P.in[I_X], nullptr, nullptr, nullptr, gw, NGW, lane); }
    GRID_SYNC();
    for (int layer = 0; layer < DEPTH; ++layer) {
        if (PEN(1)) { PH_BEGIN
          pg8::Gemm g{WSP(bf16, WS_XB), WSP(const bf16, WS_W + W_IN), T, ZP, 1024}; pg8::StaticOrder So; So.init(T, ZP, G, bx);
          pg8::EpiZ E{WSP(bf16, WS_RA), WSP(float, WS_RINVX), WSP(float, WS_LF), P.in[I_FOXB] + layer * 6};
          pg8::gemm_phase<pg8::EpiZ, pg8::StaticOrder, true, true>(L, g, So, E); }
        GRID_SYNC();
        if (PEN(2)) { PH_BEGIN
          for (int u = bx; u < 1024 + 1536 + 256; u += G) {
            if (u < 1024) { sgu_unit(P, layer, u >> 9, (u >> 2) & 127, u & 3, (char*)lds); }
            else if (u < 2560) { const int v = u - 1024, bh = v / NCH, c = v % NCH; ret1_unit(P, pp_->lg2gam[bh % 6], bh / 6, bh % 6, c, (char*)lds); }
            else { const int v = u - 2560; cum_unit(P, v >> 7, v & 127); } } }
        GRID_SYNC();
        if (PEN(3)) { PH_BEGIN
          float* ST = (float*)(ws + WS_RB + 64 * MiB);
          for (int e = bx * 512 + tid; e < 12 * 4096; e += G * 512) { const int bh = e >> 12, de = e & 4095; const float g128 = __builtin_amdgcn_exp2f(128.0f * pp_->lg2gam[bh % 6]);
              float* p = ST + (size_t)bh * NCH * 4096 + de; float carry = 0.f;
#pragma unroll 8
              for (int c = 0; c < NCH; ++c) { const float s = p[(size_t)c * 4096]; p[(size_t)c * 4096] = carry; carry = carry * g128 + s; } }
          const float* CT = (const float*)(ws + WS_CT); const float* CL = (const float*)(ws + WS_CL); float* C2 = (float*)(ws + WS_C2);
          for (int u = bx; u < 12 * NCH; u += G) { const int bh = u / NCH, c = u % NCH;
              if (tid < 128) { float pre = 0.f; for (int cc = 0; cc < c; ++cc) pre += CT[bh * NCH + cc];
                  const size_t i = (size_t)bh * S + (size_t)c * 128 + tid; C2[i] = (pre + CL[i]) * LOG2E; } } }
        GRID_SYNC();
        if (PEN(4)) { PH_BEGIN
          unsigned* qctr = WSP(unsigned, WS_CTL) + 64 * (1 + layer); volatile unsigned* qw = (volatile unsigned*)(lds + LDS_QW);
          for (;;) { if (tid == 0) *qw = atomicAdd(qctr, 1u);
              __syncthreads(); const unsigned u = *qw; __syncthreads();
              if (u >= 768u + 1536u) break;
              if (u < 768u) { const int qb = 63 - (int)(u / 12u), bh = (int)(u % 12u); fox_unit(P, bh / 6, bh % 6, qb, (char*)lds); }
              else { const int v = (int)u - 768, bh = v / NCH, c = v % NCH; ret3_unit(P, pp_->lg2gam[bh % 6], bh / 6, bh % 6, c, (char*)lds); } } }
        GRID_SYNC();
        if (PEN(5)) { PH_BEGIN
          pg8::Gemm g{WSP(bf16, WS_RB), WSP(const bf16, WS_W + W_O), T, 1024, 1024}; pg8::StaticOrder So; So.init(T, 1024, G, bx);
          pg8::EpiY E{WSP(bf16, WS_RA), WSP(float, WS_SSQP), 1024}; pg8::gemm_phase<pg8::EpiY, pg8::StaticOrder, true, true>(L, g, So, E); }
        GRID_SYNC();
        { PH_BEGIN
          resid_rows(P, layer == 0 ? P.in[I_X] : P.out, P.out, WSP(bf16, WS_RA), P.in[I_MIXPOST] + layer * 1024, gw, NGW, lane); }
        GRID_SYNC();
        if (PEN(7)) for (int st = 0; st < 5; ++st) {
            if (st == 2 || st == 4) { PH_BEGIN
                const int hb = (st - 2) >> 1;
                pg8::Gemm g{WSP(bf16, WS_RA) + (size_t)S * DFF, WSP(const bf16, WS_W + W_D), S, 1024, DFF}; pg8::StaticOrder So; So.init(S, 1024, G, bx);
                pg8::EpiY E{WSP(bf16, WS_RB) + (size_t)hb * S * 1024, WSP(float, WS_SSQP) + (size_t)hb * S * 16, 1024}; pg8::gemm_phase<pg8::EpiY, pg8::StaticOrder, true, true>(L, g, So, E); }
            if (st == 0 || st == 2) { PH_BEGIN
                const int hb = st >> 1;
                pg8::Gemm g{WSP(bf16, WS_XB) + (size_t)hb * S * 1024, WSP(const bf16, WS_W + W_G), S, DFF, 1024}; pg8::StaticOrder So; So.init(S, DFF, G, bx);
                pg8::EpiS E{WSP(bf16, WS_RA), WSP(float, WS_RINVX) + hb * S, DFF}; pg8::gemm_phase<pg8::EpiS, pg8::StaticOrder, true, true>(L, g, So, E); }
            if (st == 1 || st == 3) { PH_BEGIN
                const int hb = st >> 1;
                pg8::Gemm g{WSP(bf16, WS_XB) + (size_t)hb * S * 1024, WSP(const bf16, WS_W + W_U), S, DFF, 1024}; pg8::StaticOrder So; So.init(S, DFF, G, bx);
                pg8::EpiAct E{WSP(bf16, WS_RA) + (size_t)S * DFF, WSP(const bf16, WS_RA), WSP(float, WS_RINVX) + hb * S, P.in[I_CONVW] + (size_t)layer * 3 * DFF, P.in[I_CONVB] + (size_t)layer * DFF};
                pg8::gemm_phase<pg8::EpiAct, pg8::StaticOrder, true, true>(L, g, So, E); }
            GRID_SYNC();
        }
        if (PEN(10)) { PH_BEGIN
          int kd_ = 256; asm volatile("" : "+s"(kd_));
          pg8::Gemm g{WSP(const bf16, WS_PB), WSP(const bf16, WS_W + W_PP), T, 1024, kd_}; pg8::StaticOrder So; So.init(T, 1024, G, bx);
          pg8::EpiS E{WSP(bf16, WS_RA), nullptr, 1024}; pg8::gemm_phase<pg8::EpiS, pg8::StaticOrder, true, true>(L, g, So, E); }
        { PH_BEGIN
          resid_rows(P, P.out, P.out, WSP(bf16, WS_RB), P.in[I_FFNPOST] + layer * 1024, gw, NGW, lane); }
        GRID_SYNC();
        if (PEN(11)) { PH_BEGIN
          pg8::Gemm g{WSP(bf16, WS_XB), WSP(const bf16, WS_W + W_PG), T, 1024, 1024}; pg8::StaticOrder So; So.init(T, 1024, G, bx);
          pg8::EpiPle E{WSP(bf16, WS_RB), WSP(const bf16, WS_RA), WSP(float, WS_RINVX), WSP(float, WS_SSQP)}; pg8::gemm_phase<pg8::EpiPle, pg8::StaticOrder, true, true>(L, g, So, E); }
        GRID_SYNC();
        { PH_BEGIN
          resid_rows(P, P.out, P.out, WSP(bf16, WS_RB), P.in[I_PLEPOST] + layer * 1024, gw, NGW, lane);
          if (layer + 1 < DEPTH) { __syncthreads(); convert_weights(P, layer + 1, (char*)lds, gw, NGW, wave, lane); } }
        if (layer + 1 < DEPTH) GRID_SYNC();
    }
}

extern "C" void kernel_launch(void* const* d_in, const int* in_sizes, int n_in, void* d_out, int out_size, void* d_ws, size_t ws_size, hipStream_t stream) {
    static int grid = 0;
    if (grid == 0) {
        if (n_in != N_INPUTS || ws_size < WS_END) { fprintf(stderr, "kernel_launch: unexpected n_in %d / ws_size %zu\n", n_in, ws_size); grid = -1; return; }
        int dev = 0, cus = 0, per_cu = 0;
        (void)hipGetDevice(&dev); (void)hipDeviceGetAttribute(&cus, hipDeviceAttributeMultiprocessorCount, dev);
        (void)hipFuncSetAttribute((const void*)fwd_kernel, hipFuncAttributeMaxDynamicSharedMemorySize, LDS_BYTES);
        (void)hipOccupancyMaxActiveBlocksPerMultiprocessor(&per_cu, (const void*)fwd_kernel, 512, LDS_BYTES);
        if (per_cu < 1) { fprintf(stderr, "kernel_launch: occupancy query says %d blocks/CU\n", per_cu); per_cu = 1; }
        grid = cus;
    }
    if (grid < 0) return;
    (void)hipMemsetAsync((char*)d_ws + WS_CTL, 0, 4096, stream);
    Params p; memset(&p, 0, sizeof(p));
    for (int i = 0; i < N_INPUTS; ++i) p.in[i] = (const float*)d_in[i];
    p.out = (float*)d_out; p.ws = (unsigned char*)d_ws;
    for (int h = 0; h < 6; ++h) p.lg2gam[h] = (float)log2(1.0 - exp2(-5.0 - (double)h));
    void* args[] = {&p};
    hipError_t e = hipLaunchCooperativeKernel((const void*)fwd_kernel, dim3(grid), dim3(512), args, LDS_BYTES, stream);
    if (e != hipSuccess) fprintf(stderr, "cooperative launch failed: %s (grid %d)\n", hipGetErrorString(e), grid);
}
```

```cpp
#include <hip/hip_runtime.h>
#include <hip/hip_cooperative_groups.h>
#include <cstdio>
#include <cstdint>
#include <cmath>
#include <cstring>
namespace cg = cooperative_groups;
namespace pg8 {
#define PG8_LAS __attribute__((address_space(3)))
typedef unsigned short bf16_t;
typedef short bf16x8 __attribute__((ext_vector_type(8)));
typedef float f32x4 __attribute__((ext_vector_type(4)));
typedef unsigned u32x4 __attribute__((ext_vector_type(4)));
constexpr int BM = 256, BK = 64, HALF = 128, HTB = HALF * BK * 2  , STAGE_BYTES = 8 * HTB, NXCD = 8, WGM = 8;

__host__ __device__ __forceinline__ int lds_byte(int r, int c) { const int st = (r >> 4) * 2 + (c >> 5), rr = r & 15, cc = c & 31, ob = rr * 64 + cc * 2; return st * 1024 + (ob ^ (((ob >> 9) & 1) << 5)); }
__host__ __device__ __forceinline__ void stage_rc(int b, int& R, int& C) { const int st = b / 1024, sb = b % 1024, swz = sb ^ (((sb >> 9) & 1) << 5); R = (st >> 1) * 16 + swz / 64; C = (st & 1) * 32 + (swz % 64) / 2; }
__host__ __device__ __forceinline__ int perm32(int rho) { const int n = rho >> 4, i = rho & 15; return 8 * (i >> 2) + 4 * n + (i & 3); }

struct Unit { int pm, pn; };
struct Gemm { const bf16_t* A; const bf16_t* Bt; int M, N, K; };

struct StaticOrder {
    int nM, nN, nwg, G, c;
    __host__ __device__ void init(int M, int N, int G_, int c_) { nM = M / BM; nN = N / BM; nwg = nM * nN; G = G_; c = c_; }
    __host__ __device__ bool next(int i, Unit& u) const {
        const long L = (long)i * G + c; if (L >= nwg) return false;
        int wgid = (int)L; { const int q = nwg / NXCD, r = nwg % NXCD, xcd = wgid % NXCD, off = wgid / NXCD; wgid = (xcd < r ? xcd * (q + 1) : r * (q + 1) + (xcd - r) * q) + off; }
        const int nig = WGM * nN, gid = wgid / nig, fm = gid * WGM, gsz = (nM - fm) < WGM ? (nM - fm) : WGM;
        u.pm = fm + ((wgid % nig) % gsz); u.pn = (wgid % nig) / gsz; return true;
    }
    __device__ __forceinline__ void a_ready(const Unit&) const {}
    __device__ __forceinline__ void done(const Unit&) const {}
};

__device__ __forceinline__ unsigned cvt_pk_bf16(float lo, float hi) { unsigned r; asm volatile("v_cvt_pk_bf16_f32 %0, %1, %2" : "=v"(r) : "v"(lo), "v"(hi)); return r; }
typedef float f32x2 __attribute__((ext_vector_type(2)));
__device__ __forceinline__ f32x2 gelu_pk(f32x2 v) {
    const f32x2 av = __builtin_elementwise_abs(v), d = av * 0.2316418882f + 1.0f;
    f32x2 t; t.x = __builtin_amdgcn_rcpf(d.x); t.y = __builtin_amdgcn_rcpf(d.y);
    f32x2 q = t * 0.5307027145f + (-0.7265760135f); q = q * t + 0.7107068705f; q = q * t + (-0.142248368f); q = q * t + 0.127414796f; q = q * t;
    const f32x2 s = (v * v) * (-0.72134752044f);
    f32x2 e; e.x = __builtin_amdgcn_exp2f(s.x); e.y = __builtin_amdgcn_exp2f(s.y);
    const f32x2 m = v * (q * e), r = v - m;
    f32x2 o; o.x = v.x < 0.f ? m.x : r.x; o.y = v.y < 0.f ? m.y : r.y; return o;
}

template <int ACT  > struct EpiBf16 {
    static constexpr bool PERM = true, AFTER_DRAIN = false; static_assert(ACT == 0 || ACT == 1, "EpiBf16: ACT is 0 (none) or 1 (gelu_pk)");
    bf16_t* O; int ldc; const float* bias; int split_cols; size_t split_stride; float scale0;
    __device__ __forceinline__ void operator()(const f32x4 (&acc)[2][2][4][2], const Unit& u, int wr, int wc, int fr, int fq) const {
        const int row0 = u.pm * BM + wr * 64 + fr; int colt = u.pn * BM; bf16_t* base = O;
        float sc = 1.f; if (split_cols) { const int t = colt / split_cols; base += (size_t)t * split_stride; colt -= t * split_cols; if (t == 0) sc = scale0; }
        const int col0 = colt + wc * 32 + 8 * fq, bcol0 = u.pn * BM + wc * 32 + 8 * fq;
        f32x4 bv[2][2];
#pragma unroll
        for (int bj = 0; bj < 2; ++bj)
#pragma unroll
            for (int n = 0; n < 2; ++n) bv[bj][n] = bias ? *(const f32x4*)(bias + bcol0 + bj * HALF + 4 * n) : (f32x4){0.f, 0.f, 0.f, 0.f};
#pragma unroll
        for (int ai = 0; ai < 2; ++ai)
#pragma unroll
            for (int m = 0; m < 4; ++m) { bf16_t* rowp = base + (size_t)(row0 + ai * HALF + m * 16) * ldc + col0;
#pragma unroll
                for (int bj = 0; bj < 2; ++bj) { f32x4 v0 = acc[ai][bj][m][0] + bv[bj][0], v1 = acc[ai][bj][m][1] + bv[bj][1];
                    if (ACT == 1) { f32x2 a = gelu_pk((f32x2){v0[0], v0[1]}), b = gelu_pk((f32x2){v0[2], v0[3]}), c = gelu_pk((f32x2){v1[0], v1[1]}), d = gelu_pk((f32x2){v1[2], v1[3]});
                        v0 = (f32x4){a.x, a.y, b.x, b.y}; v1 = (f32x4){c.x, c.y, d.x, d.y}; }
                    v0 = v0 * sc; v1 = v1 * sc; u32x4 w; w.x = cvt_pk_bf16(v0[0], v0[1]); w.y = cvt_pk_bf16(v0[2], v0[3]); w.z = cvt_pk_bf16(v1[0], v1[1]); w.w = cvt_pk_bf16(v1[2], v1[3]);
                    *(u32x4*)(rowp + bj * HALF) = w; } }
    }
};

typedef float f32x2_t __attribute__((ext_vector_type(2))); typedef __bf16 bf16x2_t __attribute__((ext_vector_type(2)));
__device__ __forceinline__ unsigned pk2(float lo, float hi) { f32x2_t v = {lo, hi}; bf16x2_t b = __builtin_convertvector(v, bf16x2_t); return __builtin_bit_cast(unsigned, b); }
__device__ __forceinline__ float bflo(unsigned w) { return __uint_as_float(w << 16); }
__device__ __forceinline__ float bfhi(unsigned w) { return __uint_as_float(w & 0xffff0000u); }
__device__ __forceinline__ float gelu_tanh(float x) { const float t = x * (1.0f + 0.044715f * x * x); return x * __builtin_amdgcn_rcpf(1.0f + __builtin_amdgcn_exp2f(-2.3022082f * t)); }
__device__ __forceinline__ float sigmoid_f(float x) { return __builtin_amdgcn_rcpf(1.0f + __builtin_amdgcn_exp2f(-1.4426950409f * x)); }
__device__ __forceinline__ float logsigmoid_f(float x) { return fminf(x, 0.f) - log1pf(__expf(-fabsf(x))); }
constexpr int ZP = 3328;
struct EpiZ {
    static constexpr bool PERM = true, AFTER_DRAIN = false;
    bf16_t* Z; const float* rinv; float* LF; const float* bfv;
    __device__ __forceinline__ void operator()(const f32x4 (&acc)[2][2][4][2], const Unit& u, int wr, int wc, int fr, int fq) const {
        const int row0 = u.pm * BM + wr * 64 + fr, colb = u.pn * BM + wc * 32 + 8 * fq; const bool dog = u.pn < 2; const bool dof = (u.pn == 12) && (wc == 0) && (fq == 0);
#pragma unroll
        for (int ai = 0; ai < 2; ++ai)
#pragma unroll
            for (int m = 0; m < 4; ++m) { const int row = row0 + ai * HALF + m * 16; const float sc = rinv[row]; bf16_t* rowp = Z + (size_t)row * ZP + colb;
#pragma unroll
                for (int bj = 0; bj < 2; ++bj) { f32x4 v0 = acc[ai][bj][m][0] * sc, v1 = acc[ai][bj][m][1] * sc;
                    if (dog) { v0[0] = gelu_tanh(v0[0]); v0[1] = gelu_tanh(v0[1]); v0[2] = gelu_tanh(v0[2]); v0[3] = gelu_tanh(v0[3]); v1[0] = gelu_tanh(v1[0]); v1[1] = gelu_tanh(v1[1]); v1[2] = gelu_tanh(v1[2]); v1[3] = gelu_tanh(v1[3]); }
                    u32x4 w; w.x = pk2(v0[0], v0[1]); w.y = pk2(v0[2], v0[3]); w.z = pk2(v1[0], v1[1]); w.w = pk2(v1[2], v1[3]);
                    *(u32x4*)(rowp + bj * HALF) = w;
                    if (bj == 1 && dof) { float* lf = LF + (size_t)row * 8;
                        lf[0] = logsigmoid_f(v0[0] + bfv[0]); lf[1] = logsigmoid_f(v0[1] + bfv[1]); lf[2] = logsigmoid_f(v0[2] + bfv[2]); lf[3] = logsigmoid_f(v0[3] + bfv[3]);
                        lf[4] = logsigmoid_f(v1[0] + bfv[4]); lf[5] = logsigmoid_f(v1[1] + bfv[5]); } } }
    }
};
struct EpiY {
    static constexpr bool PERM = true, AFTER_DRAIN = false;
    bf16_t* Y; float* ssq; int ldc;
    __device__ __forceinline__ void operator()(const f32x4 (&acc)[2][2][4][2], const Unit& u, int wr, int wc, int fr, int fq) const {
        const int row0 = u.pm * BM + wr * 64 + fr, colb = u.pn * BM + wc * 32 + 8 * fq;
#pragma unroll
        for (int ai = 0; ai < 2; ++ai)
#pragma unroll
            for (int m = 0; m < 4; ++m) { const int row = row0 + ai * HALF + m * 16; bf16_t* rowp = Y + (size_t)row * ldc + colb; float ss = 0.f;
#pragma unroll
                for (int bj = 0; bj < 2; ++bj) { const f32x4 v0 = acc[ai][bj][m][0], v1 = acc[ai][bj][m][1];
                    ss += (v0[0] * v0[0] + v0[1] * v0[1]) + (v0[2] * v0[2] + v0[3] * v0[3]) + (v1[0] * v1[0] + v1[1] * v1[1]) + (v1[2] * v1[2] + v1[3] * v1[3]);
                    u32x4 w; w.x = pk2(v0[0], v0[1]); w.y = pk2(v0[2], v0[3]); w.z = pk2(v1[0], v1[1]); w.w = pk2(v1[2], v1[3]);
                    *(u32x4*)(rowp + bj * HALF) = w; }
                ss += __shfl_xor(ss, 16); ss += __shfl_xor(ss, 32);
                if (fq == 0) ssq[(size_t)row * 16 + (u.pn & 3) * 4 + wc] = ss; }
    }
};
struct EpiS {
    static constexpr bool PERM = true, AFTER_DRAIN = false;
    bf16_t* O; const float* rinv; int ldc;
    __device__ __forceinline__ void operator()(const f32x4 (&acc)[2][2][4][2], const Unit& u, int wr, int wc, int fr, int fq) const {
        const int row0 = u.pm * BM + wr * 64 + fr, colb = u.pn * BM + wc * 32 + 8 * fq;
#pragma unroll
        for (int ai = 0; ai < 2; ++ai)
#pragma unroll
            for (int m = 0; m < 4; ++m) { const int row = row0 + ai * HALF + m * 16; const float sc = rinv ? rinv[row] : 1.0f; bf16_t* rowp = O + (size_t)row * ldc + colb;
#pragma unroll
                for (int bj = 0; bj < 2; ++bj) { const f32x4 v0 = acc[ai][bj][m][0] * sc, v1 = acc[ai][bj][m][1] * sc;
                    u32x4 w; w.x = pk2(v0[0], v0[1]); w.y = pk2(v0[2], v0[3]); w.z = pk2(v1[0], v1[1]); w.w = pk2(v1[2], v1[3]);
                    *(u32x4*)(rowp + bj * HALF) = w; } }
    }
};
struct EpiAct {
    static constexpr bool PERM = true, AFTER_DRAIN = false;
    bf16_t* ACT; const bf16_t* G; const float* rinv; const float* cw; const float* cb;
    __device__ __forceinline__ void operator()(const f32x4 (&acc)[2][2][4][2], const Unit& u, int wr, int wc, int fr, int fq) const {
        const int row0 = u.pm * BM + wr * 64 + fr, colb = u.pn * BM + wc * 32 + 8 * fq;
#pragma unroll
        for (int bj = 0; bj < 2; ++bj) { const int col = colb + bj * HALF;
            float w0[8], w1[8], w2[8], b0[8];
#pragma unroll
            for (int j = 0; j < 2; ++j) { const f32x4 a = *(const f32x4*)(cw + col + 4 * j), b = *(const f32x4*)(cw + 4096 + col + 4 * j), c = *(const f32x4*)(cw + 8192 + col + 4 * j), d = *(const f32x4*)(cb + col + 4 * j);
#pragma unroll
                for (int k = 0; k < 4; ++k) { w0[4 * j + k] = a[k]; w1[4 * j + k] = b[k]; w2[4 * j + k] = c[k]; b0[4 * j + k] = d[k]; } }
#pragma unroll
            for (int ai = 0; ai < 2; ++ai)
#pragma unroll
                for (int m = 0; m < 4; ++m) { const int row = row0 + ai * HALF + m * 16; const float sc = rinv[row];
                    const bf16_t* gp = G + (size_t)row * 4096 + col; const u32x4 z4 = {0u, 0u, 0u, 0u};
                    const u32x4 g2 = *(const u32x4*)gp; const u32x4 g1 = row >= 1 ? *(const u32x4*)(gp - 4096) : z4; const u32x4 g0 = row >= 2 ? *(const u32x4*)(gp - 8192) : z4;
                    float o[8];
#pragma unroll
                    for (int k = 0; k < 4; ++k) { const unsigned a = g0[k], b = g1[k], c = g2[k];
                        const float c0 = b0[2 * k] + w0[2 * k] * bflo(a) + w1[2 * k] * bflo(b) + w2[2 * k] * bflo(c);
                        const float c1 = b0[2 * k + 1] + w0[2 * k + 1] * bfhi(a) + w1[2 * k + 1] * bfhi(b) + w2[2 * k + 1] * bfhi(c);
                        const float u0 = (k < 2 ? acc[ai][bj][m][0][2 * k] : acc[ai][bj][m][1][2 * k - 4]) * sc, u1 = (k < 2 ? acc[ai][bj][m][0][2 * k + 1] : acc[ai][bj][m][1][2 * k - 3]) * sc;
                        o[2 * k] = gelu_tanh(c0) * u0; o[2 * k + 1] = gelu_tanh(c1) * u1; }
                    u32x4 w; w.x = pk2(o[0], o[1]); w.y = pk2(o[2], o[3]); w.z = pk2(o[4], o[5]); w.w = pk2(o[6], o[7]);
                    *(u32x4*)(ACT + (size_t)row * 4096 + col) = w; } }
    }
};
struct EpiPle {
    static constexpr bool PERM = true, AFTER_DRAIN = false;
    bf16_t* Y; const bf16_t* E; const float* rinv; float* ssq;
    __device__ __forceinline__ void operator()(const f32x4 (&acc)[2][2][4][2], const Unit& u, int wr, int wc, int fr, int fq) const {
        const int row0 = u.pm * BM + wr * 64 + fr, colb = u.pn * BM + wc * 32 + 8 * fq;
#pragma unroll
        for (int ai = 0; ai < 2; ++ai)
#pragma unroll
            for (int m = 0; m < 4; ++m) { const int row = row0 + ai * HALF + m * 16; const float sc = rinv[row]; float ss = 0.f;
#pragma unroll
                for (int bj = 0; bj < 2; ++bj) { const size_t off = (size_t)row * 1024 + colb + bj * HALF; const u32x4 e = *(const u32x4*)(E + off);
                    const f32x4 v0 = acc[ai][bj][m][0] * sc, v1 = acc[ai][bj][m][1] * sc; float o[8];
                    o[0] = bflo(e.x) * sigmoid_f(v0[0]); o[1] = bfhi(e.x) * sigmoid_f(v0[1]); o[2] = bflo(e.y) * sigmoid_f(v0[2]); o[3] = bfhi(e.y) * sigmoid_f(v0[3]);
                    o[4] = bflo(e.z) * sigmoid_f(v1[0]); o[5] = bfhi(e.z) * sigmoid_f(v1[1]); o[6] = bflo(e.w) * sigmoid_f(v1[2]); o[7] = bfhi(e.w) * sigmoid_f(v1[3]);
#pragma unroll
                    for (int k = 0; k < 8; ++k) ss += o[k] * o[k];
                    u32x4 w; w.x = pk2(o[0], o[1]); w.y = pk2(o[2], o[3]); w.z = pk2(o[4], o[5]); w.w = pk2(o[6], o[7]);
                    *(u32x4*)(Y + off) = w; }
                ss += __shfl_xor(ss, 16); ss += __shfl_xor(ss, 32);
                if (fq == 0) ssq[(size_t)row * 16 + (u.pn & 3) * 4 + wc] = ss; }
    }
};
template <class Epi, class Sched, bool ALIGN_EPI = false, bool SP2 = false>
__device__ __forceinline__ void gemm_phase(PG8_LAS unsigned char* lds, const Gemm g, const Sched& S, const Epi& E) {
    int tid_o = threadIdx.x; asm volatile("" : "+v"(tid_o));
    const int tid = tid_o, wid = __builtin_amdgcn_readfirstlane(tid >> 6), lane = tid & 63, wr = wid >> 2, wc = wid & 3, fr = lane & 15, fq = lane >> 4;
    const int K = g.K, nt = K / BK;
    unsigned voffA[2], voffB[2];
#pragma unroll
    for (int i = 0; i < 2; ++i) { int R, C; stage_rc(tid * 16 + i * 8192, R, C); const int Rb = Epi::PERM ? ((R & ~31) + perm32(R & 31)) : R;
        voffA[i] = (unsigned)(R * K + C) * 2u; voffB[i] = (unsigned)(Rb * K + C) * 2u; }
    const size_t kstep = (size_t)(BK * 2);
    const size_t hstep = (size_t)HALF * K * 2;
    const size_t tstep = 2 * hstep;
    const unsigned ldsw = (unsigned)wid * 1024u;
    const int aoff = lds_byte(wr * 64 + fr, fq * 8), boff = lds_byte(wc * 32 + fr, fq * 8);
#define PG8_SA(b, h) (((b) * 2 + (h)) * HTB)
#define PG8_SB(b, h) ((4 + (b) * 2 + (h)) * HTB)
#define PG8_STAGE(bufoff, gbase, voff) do { _Pragma("unroll") for (int _i = 0; _i < 2; ++_i) \
        __builtin_amdgcn_global_load_lds((const unsigned*)((const char*)(gbase) + (voff)[_i]), (PG8_LAS unsigned*)(lds + (bufoff) + ldsw + _i * 8192), 16, 0, 0); } while (0)
#define PG8_LDA(dst, b, h) do { _Pragma("unroll") for (int m = 0; m < 4; ++m) _Pragma("unroll") for (int k = 0; k < 2; ++k) dst[m][k] = *(const PG8_LAS bf16x8*)(lds + PG8_SA(b, h) + aoff + m * 2048 + k * 1024); } while (0)
#define PG8_LDB(dst, b, h) do { _Pragma("unroll") for (int n = 0; n < 2; ++n) _Pragma("unroll") for (int k = 0; k < 2; ++k) dst[n][k] = *(const PG8_LAS bf16x8*)(lds + PG8_SB(b, h) + boff + n * 2048 + k * 1024); } while (0)
#define PG8_MMA(ai, bj, At, Bt) do { __builtin_amdgcn_s_setprio(1); _Pragma("unroll") for (int m = 0; m < 4; ++m) _Pragma("unroll") for (int n = 0; n < 2; ++n) _Pragma("unroll") for (int k = 0; k < 2; ++k) \
        acc[ai][bj][m][n] = __builtin_amdgcn_mfma_f32_16x16x32_bf16(Bt[n][k], At[m][k], acc[ai][bj][m][n], 0, 0, 0); __builtin_amdgcn_s_setprio(0); } while (0)
#define PG8_WAIT_V(n) asm volatile("s_waitcnt vmcnt(" #n ")" ::: "memory")
#define PG8_WAIT_L(n) asm volatile("s_waitcnt lgkmcnt(" #n ")" ::: "memory")
#define PG8_BAR __builtin_amdgcn_s_barrier()
#define PG8_SCHED __builtin_amdgcn_sched_barrier(0)
    Unit cur, nxt; int ui = 0;
    if (!S.next(0, cur)) return;
    f32x4 acc[2][2][4][2];
#pragma unroll
    for (int a = 0; a < 2; ++a)
#pragma unroll
        for (int b = 0; b < 2; ++b)
#pragma unroll
            for (int m = 0; m < 4; ++m)
#pragma unroll
                for (int n = 0; n < 2; ++n) acc[a][b][m][n] = (f32x4){0.f, 0.f, 0.f, 0.f};
    bf16x8 At[4][2], B0[2][2], B1[2][2];
    const char* cA = (const char*)g.A + (size_t)cur.pm * tstep; const char* cB = (const char*)g.Bt + (size_t)cur.pn * tstep;
    S.a_ready(cur);
    if constexpr (SP2) {
        PG8_STAGE(PG8_SB(0, 0), cB, voffB); PG8_STAGE(PG8_SB(0, 1), cB + hstep, voffB); PG8_STAGE(PG8_SA(0, 0), cA, voffA); PG8_STAGE(PG8_SA(0, 1), cA + hstep, voffA);
        if (wr == 1) PG8_BAR;
        PG8_WAIT_V(2); PG8_BAR;
        PG8_STAGE(PG8_SB(1, 0), cB + kstep, voffB); PG8_STAGE(PG8_SA(1, 0), cA + kstep, voffA); PG8_STAGE(PG8_SB(1, 1), cB + hstep + kstep, voffB);
        PG8_WAIT_V(6); PG8_BAR;
    } else {
        PG8_STAGE(PG8_SB(0, 0), cB, voffB); PG8_STAGE(PG8_SA(0, 0), cA, voffA); PG8_STAGE(PG8_SB(0, 1), cB + hstep, voffB); PG8_STAGE(PG8_SA(0, 1), cA + hstep, voffA);
        if (wr == 1) PG8_BAR;
        PG8_WAIT_V(4); PG8_BAR;
        PG8_STAGE(PG8_SB(1, 0), cB + kstep, voffB); PG8_STAGE(PG8_SA(1, 0), cA + kstep, voffA); PG8_STAGE(PG8_SB(1, 1), cB + hstep + kstep, voffB);
        PG8_WAIT_V(6); PG8_BAR;
    }
    for (;;) {
        const bool has_next = S.next(ui + 1, nxt);
        const char* nA = has_next ? (const char*)g.A + (size_t)nxt.pm * tstep : cA; const char* nB = has_next ? (const char*)g.Bt + (size_t)nxt.pn * tstep : cB;
        for (int t = 0; t < nt; t += 2) {
            const bool last = (t == nt - 2);
            const char* a1 = cA + (size_t)(t + 1) * kstep;
            const char* a2 = last ? nA : cA + (size_t)(t + 2) * kstep; const char* b2 = last ? nB : cB + (size_t)(t + 2) * kstep;
            const char* a3 = a2 + kstep; const char* b3 = b2 + kstep;
            if (last && has_next) S.a_ready(nxt);
            if constexpr (SP2) {
            PG8_LDB(B0, 0, 0); PG8_LDB(B1, 0, 1); PG8_SCHED; PG8_LDA(At, 0, 0); PG8_STAGE(PG8_SA(1, 1), a1 + hstep, voffA);
            PG8_WAIT_V(8); PG8_WAIT_L(0); PG8_BAR; PG8_MMA(0, 0, At, B0); PG8_MMA(0, 1, At, B1); PG8_BAR; PG8_SCHED;
            PG8_LDA(At, 0, 1); PG8_STAGE(PG8_SB(0, 0), b2, voffB); PG8_STAGE(PG8_SB(0, 1), b2 + hstep, voffB); PG8_STAGE(PG8_SA(0, 0), a2, voffA);
            PG8_WAIT_V(8); PG8_WAIT_L(0); PG8_BAR; PG8_MMA(1, 0, At, B0); PG8_MMA(1, 1, At, B1); PG8_BAR; PG8_SCHED;
            PG8_LDB(B0, 1, 0); PG8_LDB(B1, 1, 1); PG8_SCHED; PG8_LDA(At, 1, 0); PG8_STAGE(PG8_SA(0, 1), a2 + hstep, voffA);
            PG8_WAIT_V(8); PG8_WAIT_L(0); PG8_BAR; PG8_MMA(0, 0, At, B0); PG8_MMA(0, 1, At, B1); PG8_BAR; PG8_SCHED;
            PG8_LDA(At, 1, 1); PG8_STAGE(PG8_SB(1, 0), b3, voffB); PG8_STAGE(PG8_SB(1, 1), b3 + hstep, voffB); PG8_STAGE(PG8_SA(1, 0), a3, voffA);
            PG8_WAIT_V(8); PG8_WAIT_L(0); PG8_BAR; PG8_MMA(1, 0, At, B0); PG8_MMA(1, 1, At, B1); PG8_BAR; PG8_SCHED;
            } else {
            PG8_LDB(B0, 0, 0); PG8_SCHED; PG8_LDA(At, 0, 0); PG8_STAGE(PG8_SA(1, 1), a1 + hstep, voffA);
            PG8_WAIT_L(8); PG8_BAR; PG8_WAIT_L(0); PG8_MMA(0, 0, At, B0); PG8_BAR; PG8_SCHED;
            PG8_LDB(B1, 0, 1); PG8_STAGE(PG8_SB(0, 0), b2, voffB);
            PG8_BAR; PG8_WAIT_L(0); PG8_MMA(0, 1, At, B1); PG8_BAR;
            PG8_LDA(At, 0, 1); PG8_STAGE(PG8_SA(0, 0), a2, voffA);
            PG8_BAR; PG8_WAIT_L(0); PG8_MMA(1, 0, At, B0); PG8_BAR; PG8_SCHED;
            PG8_STAGE(PG8_SB(0, 1), b2 + hstep, voffB);
            PG8_WAIT_V(6); PG8_BAR; PG8_MMA(1, 1, At, B1); PG8_BAR;
            PG8_LDB(B0, 1, 0); PG8_SCHED; PG8_LDA(At, 1, 0); PG8_STAGE(PG8_SA(0, 1), a2 + hstep, voffA);
            PG8_WAIT_L(8); PG8_BAR; PG8_WAIT_L(0); PG8_MMA(0, 0, At, B0); PG8_BAR; PG8_SCHED;
            PG8_LDB(B1, 1, 1); PG8_STAGE(PG8_SB(1, 0), b3, voffB);
            PG8_BAR; PG8_WAIT_L(0); PG8_MMA(0, 1, At, B1); PG8_BAR;
            PG8_LDA(At, 1, 1); PG8_STAGE(PG8_SA(1, 0), a3, voffA);
            PG8_BAR; PG8_WAIT_L(0); PG8_MMA(1, 0, At, B0); PG8_BAR; PG8_SCHED;
            PG8_STAGE(PG8_SB(1, 1), b3 + hstep, voffB);
            PG8_WAIT_V(6); PG8_BAR; PG8_MMA(1, 1, At, B1); PG8_BAR;
            }
        }
        if constexpr (ALIGN_EPI) { if (wr == 0) PG8_BAR; }
        if constexpr (!Epi::AFTER_DRAIN) { E(acc, cur, wr, wc, fr, fq); S.done(cur); }
        if (!has_next) break;
#pragma unroll
        for (int a = 0; a < 2; ++a)
#pragma unroll
            for (int b = 0; b < 2; ++b)
#pragma unroll
                for (int m = 0; m < 4; ++m)
#pragma unroll
                    for (int n = 0; n < 2; ++n) acc[a][b][m][n] = (f32x4){0.f, 0.f, 0.f, 0.f};
        cur = nxt; cA = nA; cB = nB; ++ui;
        if constexpr (ALIGN_EPI) { if (wr == 1) PG8_BAR; }
    }
    PG8_WAIT_V(0);
    if constexpr (!ALIGN_EPI) { if (wr == 0) PG8_BAR; }
    PG8_BAR;
    if constexpr (Epi::AFTER_DRAIN) { E.fused(acc, cur, wr, wc, fr, fq, lds, wid, lane); S.done(cur); }
#undef PG8_SA
#undef PG8_SB
#undef PG8_STAGE
#undef PG8_LDA
#undef PG8_LDB
#undef PG8_MMA
#undef PG8_WAIT_V
#undef PG8_WAIT_L
#undef PG8_BAR
#undef PG8_SCHED
}
}
#define DI __device__ __forceinline__
typedef unsigned short bf16;
typedef short bf16x8 __attribute__((ext_vector_type(8)));
typedef float f32x4 __attribute__((ext_vector_type(4)));
typedef float f32x16 __attribute__((ext_vector_type(16)));
typedef unsigned u32x4 __attribute__((ext_vector_type(4)));
typedef unsigned u32x2 __attribute__((ext_vector_type(2)));
using pg8::pk2; using pg8::bflo; using pg8::bfhi; using pg8::ZP;
#define MFMA32(a, b, c) __builtin_amdgcn_mfma_f32_32x32x16_bf16((a), (b), (c), 0, 0, 0)
constexpr int NB = 2, S = 16384, T = NB * S, DM = 1024, DEPTH = 2, DFF = 4096, NIN = 3206;
constexpr float EPS = 1e-6f, LOG2E = 1.4426950408889634f;
constexpr int NCH = S / 128;
enum { I_X = 0, I_P, I_POS, I_MIXPRE, I_WIN, I_SGUVG, I_SGUW, I_SGUB, I_FOXB, I_WO, I_MIXPOST, I_FFNPRE, I_WGATE, I_WUP, I_CONVW, I_CONVB, I_WDOWN, I_FFNPOST, I_PLEPRE, I_WPG, I_WPP, I_PLEPOST, N_INPUTS };
constexpr size_t MiB = 1u << 20;
constexpr size_t WS_CTL = 0;
constexpr size_t WS_RINVX = 1 * MiB;
constexpr size_t WS_SSQY = WS_RINVX + 128 * 1024;
constexpr size_t WS_CT = WS_SSQY + 128 * 1024;
constexpr size_t WS_KN = WS_CT + 8 * 1024;
constexpr size_t WS_KPMS = WS_CT + 16 * 1024;
constexpr size_t WS_LF = 2 * MiB;
constexpr size_t WS_CL = 3 * MiB;
constexpr size_t WS_C2 = 4 * MiB;
constexpr size_t WS_COS = 5 * MiB;
constexpr size_t WS_SIN = 9 * MiB;
constexpr size_t WS_SSQP = 13 * MiB;
constexpr size_t WS_W = 16 * MiB;
constexpr size_t W_IN = 0, W_O = W_IN + (size_t)ZP * 1024 * 2, W_G = W_O + 2 * MiB, W_U = W_G + 8 * MiB, W_D = W_U + 8 * MiB, W_PG = W_D + 8 * MiB, W_PP = W_PG + 2 * MiB;
constexpr size_t WS_PB = 52 * MiB;
constexpr size_t WS_XB = 68 * MiB;
constexpr size_t WS_RB = 132 * MiB;
constexpr size_t WS_RA = 232 * MiB;
constexpr size_t WS_END = 488 * MiB;
static_assert(W_PP + 512 * 1024 <= 36 * MiB, "weights");

struct Params { const float* in[N_INPUTS]; float* out; unsigned char* ws; float lg2gam[6]; int pad[2]; };

DI float wave_sum(float v) {
#pragma unroll
    for (int o = 1; o < 64; o <<= 1) v += __shfl_xor(v, o);
    return v;
}
DI int crow(int reg, int h) { return (reg & 3) + 8 * (reg >> 2) + 4 * h; }
DI unsigned short f2bf(float f) { return (unsigned short)(pk2(f, 0.f) & 0xffffu); }
DI float bf2f(unsigned short h) { return __uint_as_float((unsigned)h << 16); }
DI bf16x8 pack8(const f32x16& x, int s8) { u32x4 p; p.x = pk2(x[s8], x[s8 + 1]); p.y = pk2(x[s8 + 2], x[s8 + 3]); p.z = pk2(x[s8 + 4], x[s8 + 5]); p.w = pk2(x[s8 + 6], x[s8 + 7]); return __builtin_bit_cast(bf16x8, p); }

DI void transpose_item(const float* W, const float* g, int K, int N, int nblk, bf16* WT, float* scr, int item, int lane) {
    const int kb = item / nblk, nb = item % nblk, k0 = 64 * kb, n0 = 32 * nb;
    const int n = n0 + (lane & 31); const bool ok = n < N;
#pragma unroll 8
    for (int i = 0; i < 32; ++i) { const int kk = 2 * i + (lane >> 5); float v = ok ? W[(size_t)(k0 + kk) * N + n] : 0.f; if (g) v *= g[k0 + kk]; scr[kk * 33 + (lane & 31)] = v; }
    asm volatile("s_waitcnt lgkmcnt(0)" ::: "memory");
    const int c = lane & 7;
#pragma unroll
    for (int j = 0; j < 4; ++j) { const int nn = (lane >> 3) + 8 * j; const float* s = scr + (8 * c) * 33 + nn;
        u32x4 o; o.x = pk2(s[0 * 33], s[1 * 33]); o.y = pk2(s[2 * 33], s[3 * 33]); o.z = pk2(s[4 * 33], s[5 * 33]); o.w = pk2(s[6 * 33], s[7 * 33]);
        *(u32x4*)(WT + (size_t)(n0 + nn) * K + k0 + 8 * c) = o; }
    asm volatile("s_waitcnt lgkmcnt(0)" ::: "memory");
}
DI void convert_weights(const Params& P, int layer, char* lds, int gw, int NGW, int wave, int lane) {
    float* scr = (float*)(lds + wave * 16384);
    unsigned char* wb = P.ws + WS_W;
    constexpr int I_IN = 16 * 104, I_O = 16 * 32, I_G = 16 * 128, I_D = 64 * 32, I_PG = 16 * 32, I_PP = 4 * 32;
    constexpr int NITEMS = I_IN + I_O + 2 * I_G + I_D + I_PG + I_PP;
    for (int it = gw; it < NITEMS; it += NGW) {
        int r = it;
        if (r < I_IN) { transpose_item(P.in[I_WIN] + (size_t)layer * 1024 * NIN, P.in[I_MIXPRE] + layer * 1024, 1024, NIN, 104, (bf16*)(wb + W_IN), scr, r, lane); continue; } r -= I_IN;
        if (r < I_O) { transpose_item(P.in[I_WO] + (size_t)layer * 1024 * 1024, nullptr, 1024, 1024, 32, (bf16*)(wb + W_O), scr, r, lane); continue; } r -= I_O;
        if (r < I_G) { transpose_item(P.in[I_WGATE] + (size_t)layer * 1024 * DFF, P.in[I_FFNPRE] + layer * 1024, 1024, DFF, 128, (bf16*)(wb + W_G), scr, r, lane); continue; } r -= I_G;
        if (r < I_G) { transpose_item(P.in[I_WUP] + (size_t)layer * 1024 * DFF, P.in[I_FFNPRE] + layer * 1024, 1024, DFF, 128, (bf16*)(wb + W_U), scr, r, lane); continue; } r -= I_G;
        if (r < I_D) { transpose_item(P.in[I_WDOWN] + (size_t)layer * DFF * 1024, nullptr, DFF, 1024, 32, (bf16*)(wb + W_D), scr, r, lane); continue; } r -= I_D;
        if (r < I_PG) { transpose_item(P.in[I_WPG] + (size_t)layer * 1024 * 1024, P.in[I_PLEPRE] + layer * 1024, 1024, 1024, 32, (bf16*)(wb + W_PG), scr, r, lane); continue; } r -= I_PG;
        transpose_item(P.in[I_WPP] + (size_t)layer * 256 * 1024, nullptr, 256, 1024, 32, (bf16*)(wb + W_PP), scr, r, lane);
    }
    const float* pp = P.in[I_P] + (size_t)layer * T * 256; bf16* pb = (bf16*)(P.ws + WS_PB);
    for (size_t i = (size_t)gw * 64 + lane; i < (size_t)T * 256 / 8; i += (size_t)NGW * 64) {
        const f32x4 a = *(const f32x4*)(pp + i * 8), b = *(const f32x4*)(pp + i * 8 + 4);
        u32x4 o; o.x = pk2(a[0], a[1]); o.y = pk2(a[2], a[3]); o.z = pk2(b[0], b[1]); o.w = pk2(b[2], b[3]);
        *(u32x4*)(pb + i * 8) = o; }
}
DI void resid_rows(const Params& P, const float* xsrc, float* xdst, const bf16* Y, const float* gain, int gw, int NGW, int lane) {
    const float* ssqp = (const float*)(P.ws + WS_SSQP); float* rinvx = (float*)(P.ws + WS_RINVX); bf16* XB = (bf16*)(P.ws + WS_XB);
    for (int row = gw; row < T; row += NGW) {
        const size_t off = (size_t)row * 1024 + lane * 8;
        float v[16];
#pragma unroll
        for (int j = 0; j < 2; ++j) { const f32x4 a = *(const f32x4*)(xsrc + off + j * 512), b = *(const f32x4*)(xsrc + off + j * 512 + 4);
            v[8 * j + 0] = a[0]; v[8 * j + 1] = a[1]; v[8 * j + 2] = a[2]; v[8 * j + 3] = a[3]; v[8 * j + 4] = b[0]; v[8 * j + 5] = b[1]; v[8 * j + 6] = b[2]; v[8 * j + 7] = b[3]; }
        if (Y) { float sp = lane < 16 ? ssqp[(size_t)row * 16 + lane] : 0.f; sp = wave_sum(sp); const float ry = rsqrtf(sp * (1.0f / 1024.0f) + EPS);
#pragma unroll
            for (int j = 0; j < 2; ++j) { const u32x4 y = *(const u32x4*)(Y + off + j * 512); const f32x4 g0 = *(const f32x4*)(gain + lane * 8 + j * 512), g1 = *(const f32x4*)(gain + lane * 8 + j * 512 + 4);
                v[8 * j + 0] += bflo(y.x) * ry * g0[0]; v[8 * j + 1] += bfhi(y.x) * ry * g0[1]; v[8 * j + 2] += bflo(y.y) * ry * g0[2]; v[8 * j + 3] += bfhi(y.y) * ry * g0[3];
                v[8 * j + 4] += bflo(y.z) * ry * g1[0]; v[8 * j + 5] += bfhi(y.z) * ry * g1[1]; v[8 * j + 6] += bflo(y.w) * ry * g1[2]; v[8 * j + 7] += bfhi(y.w) * ry * g1[3]; }
        }
        float ss = 0.f;
#pragma unroll
        for (int k = 0; k < 16; ++k) ss += v[k] * v[k];
        ss = wave_sum(ss);
#pragma unroll
        for (int j = 0; j < 2; ++j) {
            if (xdst) { *(f32x4*)(xdst + off + j * 512) = (f32x4){v[8 * j], v[8 * j + 1], v[8 * j + 2], v[8 * j + 3]}; *(f32x4*)(xdst + off + j * 512 + 4) = (f32x4){v[8 * j + 4], v[8 * j + 5], v[8 * j + 6], v[8 * j + 7]}; }
            u32x4 o; o.x = pk2(v[8 * j], v[8 * j + 1]); o.y = pk2(v[8 * j + 2], v[8 * j + 3]); o.z = pk2(v[8 * j + 4], v[8 * j + 5]); o.w = pk2(v[8 * j + 6], v[8 * j + 7]);
            *(u32x4*)(XB + off + j * 512) = o; }
        if (lane == 0) rinvx[row] = rsqrtf(ss * (1.0f / 1024.0f) + EPS);
    }
}
DI void rope_table(const Params& P, int gtid, int NT) {
    const int* pos = (const int*)P.in[I_POS]; float* C = (float*)(P.ws + WS_COS); float* Sn = (float*)(P.ws + WS_SIN);
    for (int i = gtid; i < T * 32; i += NT) { const int row = i >> 5, j = i & 31;
        const double invf = exp2(-(double)j * (13.287712379549449 / 32.0));
        const double ang = (double)pos[row] * invf;
        const double q = rint(ang * 0.6366197723675814); const double y = fma(-q, 1.5707963267948966, ang) - q * 6.123233995736766e-17;
        const double y2 = y * y;
        const double sp = y * (1.0 + y2 * (-1.0 / 6 + y2 * (1.0 / 120 + y2 * (-1.0 / 5040 + y2 * (1.0 / 362880 + y2 * (-1.0 / 39916800))))));
        const double cp = 1.0 + y2 * (-0.5 + y2 * (1.0 / 24 + y2 * (-1.0 / 720 + y2 * (1.0 / 40320 + y2 * (-1.0 / 3628800 + y2 * (1.0 / 479001600))))));
        const int qi = (int)((long long)q & 3);
        const double sv = (qi == 0) ? sp : (qi == 1) ? cp : (qi == 2) ? -sp : -cp;
        const double cv = (qi == 0) ? cp : (qi == 1) ? -sp : (qi == 2) ? -cp : sp;
        C[i] = (float)cv; Sn[i] = (float)sv; }
}
constexpr int ST72 = 72, ST136 = 136, ST68 = 68;
DI void sgu_unit(const Params& P, int layer, int b, int c, int hh, char* lds) {
    int tid_u = threadIdx.x; asm volatile("" : "+v"(tid_u)); const int tid = tid_u, lane = tid & 63, wid = tid >> 6, r = lane & 31, h = lane >> 5;
    bf16* Wt = (bf16*)lds; bf16* VT = Wt + 128 * ST136;
    const bf16* Z = (const bf16*)(P.ws + WS_RA); bf16* MIX = (bf16*)(P.ws + WS_RB);
    const float* W = P.in[I_SGUW] + (size_t)(layer * 4 + hh) * 128 * 128;
#pragma unroll
    for (int j = 0; j < 8; ++j) { const int idx = (j * 512 + tid) * 4, t = idx >> 7, s = idx & 127; const f32x4 w = *(const f32x4*)(W + idx);
        u32x2 o; o.x = pk2(s <= t ? w[0] : 0.f, s + 1 <= t ? w[1] : 0.f); o.y = pk2(s + 2 <= t ? w[2] : 0.f, s + 3 <= t ? w[3] : 0.f);
        *(u32x2*)(Wt + t * ST136 + s) = o; }
    const size_t row0 = (size_t)b * S + (size_t)c * 128;
    { const int s = tid >> 2, dq = tid & 3; const bf16* vp = Z + (row0 + s) * ZP + 256 + hh * 64 + dq * 16;
      const u32x4 a = *(const u32x4*)vp, bb = *(const u32x4*)(vp + 8); float v[16];
      v[0] = bflo(a.x); v[1] = bfhi(a.x); v[2] = bflo(a.y); v[3] = bfhi(a.y); v[4] = bflo(a.z); v[5] = bfhi(a.z); v[6] = bflo(a.w); v[7] = bfhi(a.w);
      v[8] = bflo(bb.x); v[9] = bfhi(bb.x); v[10] = bflo(bb.y); v[11] = bfhi(bb.y); v[12] = bflo(bb.z); v[13] = bfhi(bb.z); v[14] = bflo(bb.w); v[15] = bfhi(bb.w);
      float ss = 0.f;
#pragma unroll
      for (int i = 0; i < 16; ++i) ss += v[i] * v[i];
      ss += __shfl_xor(ss, 1); ss += __shfl_xor(ss, 2);
      const float rn = rsqrtf(ss * (1.0f / 64.0f) + EPS); const float* g = P.in[I_SGUVG] + (layer * 4 + hh) * 64 + dq * 16;
#pragma unroll
      for (int i = 0; i < 16; ++i) VT[(dq * 16 + i) * ST136 + s] = f2bf(v[i] * rn * g[i]); }
    __syncthreads();
    const int tb = wid >> 1, db = wid & 1; f32x16 acc = {};
    for (int ks = 0; ks < 2 * (tb + 1); ++ks) { const bf16x8 a = *(const bf16x8*)(Wt + (32 * tb + r) * ST136 + 16 * ks + 8 * h); const bf16x8 bb = *(const bf16x8*)(VT + (32 * db + r) * ST136 + 16 * ks + 8 * h); acc = MFMA32(a, bb, acc); }
    const float* bs = P.in[I_SGUB] + (layer * 4 + hh) * 128;
#pragma unroll
    for (int i = 0; i < 16; ++i) { const int t = 32 * tb + crow(i, h), d = 32 * db + r; const float uu = bf2f(Z[(row0 + t) * ZP + hh * 64 + d]);
        MIX[(row0 + t) * 1024 + hh * 64 + d] = f2bf(uu * (acc[i] + bs[t])); }
    __syncthreads();
}
DI void load_rot(const bf16* zh, const float* cs, const float* sn, int dq, float scale, float (&o1)[8], float (&o2)[8]) {
    const u32x4 a = *(const u32x4*)(zh + dq * 8), bb = *(const u32x4*)(zh + 32 + dq * 8);
    const f32x4 c0 = *(const f32x4*)(cs + dq * 8), c1 = *(const f32x4*)(cs + dq * 8 + 4), s0 = *(const f32x4*)(sn + dq * 8), s1 = *(const f32x4*)(sn + dq * 8 + 4);
    float x1[8] = {bflo(a.x), bfhi(a.x), bflo(a.y), bfhi(a.y), bflo(a.z), bfhi(a.z), bflo(a.w), bfhi(a.w)};
    float x2[8] = {bflo(bb.x), bfhi(bb.x), bflo(bb.y), bfhi(bb.y), bflo(bb.z), bfhi(bb.z), bflo(bb.w), bfhi(bb.w)};
#pragma unroll
    for (int j = 0; j < 8; ++j) { const float cc = j < 4 ? c0[j & 3] : c1[j & 3], sv = j < 4 ? s0[j & 3] : s1[j & 3];
        o1[j] = (x1[j] * cc - x2[j] * sv) * scale; o2[j] = (x1[j] * sv + x2[j] * cc) * scale; }
}
DI void ret1_unit(const Params& P, float lg, int b, int hh, int c, char* lds) {
    int tid_u = threadIdx.x; asm volatile("" : "+v"(tid_u)); const int tid = tid_u, lane = tid & 63, wid = tid >> 6, r = lane & 31, h = lane >> 5;
    bf16* KT = (bf16*)lds; bf16* VT = KT + 64 * ST136;
    const bf16* Z = (const bf16*)(P.ws + WS_RA); float* ST = (float*)(P.ws + WS_RB + 64 * MiB);
    const size_t row0 = (size_t)b * S + (size_t)c * 128;
    { const int s = tid >> 2, dq = tid & 3; const size_t row = row0 + s; float o1[8], o2[8];
      load_rot(Z + row * ZP + 896 + hh * 64, (const float*)(P.ws + WS_COS) + row * 32, (const float*)(P.ws + WS_SIN) + row * 32, dq, 0.125f * __builtin_amdgcn_exp2f((float)(127 - s) * lg), o1, o2);
#pragma unroll
      for (int j = 0; j < 8; ++j) { KT[(dq * 8 + j) * ST136 + s] = f2bf(o1[j]); KT[(32 + dq * 8 + j) * ST136 + s] = f2bf(o2[j]); }
      const bf16* vp = Z + row * ZP + 1280 + hh * 64 + dq * 16; const u32x4 a = *(const u32x4*)vp, bb = *(const u32x4*)(vp + 8);
      const unsigned vv[8] = {a.x, a.y, a.z, a.w, bb.x, bb.y, bb.z, bb.w};
#pragma unroll
      for (int i = 0; i < 8; ++i) { VT[(dq * 16 + 2 * i) * ST136 + s] = (bf16)(vv[i] & 0xffffu); VT[(dq * 16 + 2 * i + 1) * ST136 + s] = (bf16)(vv[i] >> 16); } }
    __syncthreads();
    if (wid < 4) { const int db = wid >> 1, eb = wid & 1; f32x16 acc = {};
#pragma unroll
        for (int ks = 0; ks < 8; ++ks) { const bf16x8 a = *(const bf16x8*)(KT + (32 * db + r) * ST136 + 16 * ks + 8 * h); const bf16x8 bb = *(const bf16x8*)(VT + (32 * eb + r) * ST136 + 16 * ks + 8 * h); acc = MFMA32(a, bb, acc); }
        float* st = ST + ((size_t)((b * 6 + hh) * NCH + c)) * 4096;
#pragma unroll
        for (int i = 0; i < 16; ++i) st[(32 * db + crow(i, h)) * 64 + 32 * eb + r] = acc[i]; }
    __syncthreads();
}
DI void cum_unit(const Params& P, int b, int c) {
    int tid_u = threadIdx.x; asm volatile("" : "+v"(tid_u)); const int tid = tid_u, lane = tid & 63, wid = tid >> 6;
    if (wid < 6) { const float* LF = (const float*)(P.ws + WS_LF); float* CL = (float*)(P.ws + WS_CL); float* CT = (float*)(P.ws + WS_CT);
        const size_t row = (size_t)b * S + (size_t)c * 128 + 2 * lane; const float v0 = LF[row * 8 + wid], v1 = LF[(row + 1) * 8 + wid];
        float x = v0 + v1;
#pragma unroll
        for (int o = 1; o < 64; o <<= 1) { const float y = __shfl_up(x, o); if (lane >= o) x += y; }
        float* cl = CL + (size_t)(b * 6 + wid) * S + (size_t)c * 128 + 2 * lane; cl[0] = x - v1; cl[1] = x;
        if (lane == 63) CT[(b * 6 + wid) * NCH + c] = x;
        const bf16* Z = (const bf16*)(P.ws + WS_RA); float km = 0.f;
#pragma unroll
        for (int rr = 0; rr < 2; ++rr) { const bf16* kp = Z + (row + rr) * ZP + 2432 + wid * 64; float ss = 0.f;
#pragma unroll
            for (int j = 0; j < 8; ++j) { const u32x4 w = *(const u32x4*)(kp + 8 * j);
                ss += bflo(w.x) * bflo(w.x) + bfhi(w.x) * bfhi(w.x) + bflo(w.y) * bflo(w.y) + bfhi(w.y) * bfhi(w.y) + bflo(w.z) * bflo(w.z) + bfhi(w.z) * bfhi(w.z) + bflo(w.w) * bflo(w.w) + bfhi(w.w) * bfhi(w.w); }
            km = fmaxf(km, ss); }
#pragma unroll
        for (int o = 1; o < 64; o <<= 1) km = fmaxf(km, __shfl_xor(km, o));
        if (lane == 0) ((float*)(P.ws + WS_KN))[(b * 6 + wid) * NCH + c] = km; }
}
DI void ret3_unit(const Params& P, float lg, int b, int hh, int c, char* lds) {
    int tid_u = threadIdx.x; asm volatile("" : "+v"(tid_u)); const int tid = tid_u, lane = tid & 63, wid = tid >> 6, r = lane & 31, h = lane >> 5;
    bf16* Q = (bf16*)lds; bf16* K = Q + 128 * ST72; bf16* VT = K + 128 * ST72; bf16* RT = VT + 64 * ST136; bf16* Pm = RT + 64 * ST72; float* O = (float*)lds;
    const bf16* Z = (const bf16*)(P.ws + WS_RA); bf16* MIX = (bf16*)(P.ws + WS_RB); const float* ST = (const float*)(P.ws + WS_RB + 64 * MiB) + ((size_t)((b * 6 + hh) * NCH + c)) * 4096;
    const size_t row0 = (size_t)b * S + (size_t)c * 128;
    { const int s = tid >> 2, dq = tid & 3; const size_t row = row0 + s; float o1[8], o2[8];
      const float* cs = (const float*)(P.ws + WS_COS) + row * 32; const float* sn = (const float*)(P.ws + WS_SIN) + row * 32;
      load_rot(Z + row * ZP + 512 + hh * 64, cs, sn, dq, 1.0f, o1, o2);
      { u32x4 w; w.x = pk2(o1[0], o1[1]); w.y = pk2(o1[2], o1[3]); w.z = pk2(o1[4], o1[5]); w.w = pk2(o1[6], o1[7]); *(u32x4*)(Q + s * ST72 + dq * 8) = w;
        w.x = pk2(o2[0], o2[1]); w.y = pk2(o2[2], o2[3]); w.z = pk2(o2[4], o2[5]); w.w = pk2(o2[6], o2[7]); *(u32x4*)(Q + s * ST72 + 32 + dq * 8) = w; }
      load_rot(Z + row * ZP + 896 + hh * 64, cs, sn, dq, 0.125f, o1, o2);
      { u32x4 w; w.x = pk2(o1[0], o1[1]); w.y = pk2(o1[2], o1[3]); w.z = pk2(o1[4], o1[5]); w.w = pk2(o1[6], o1[7]); *(u32x4*)(K + s * ST72 + dq * 8) = w;
        w.x = pk2(o2[0], o2[1]); w.y = pk2(o2[2], o2[3]); w.z = pk2(o2[4], o2[5]); w.w = pk2(o2[6], o2[7]); *(u32x4*)(K + s * ST72 + 32 + dq * 8) = w; }
      const bf16* vp = Z + row * ZP + 1280 + hh * 64 + dq * 16; const u32x4 a = *(const u32x4*)vp, bb = *(const u32x4*)(vp + 8);
      const unsigned vv[8] = {a.x, a.y, a.z, a.w, bb.x, bb.y, bb.z, bb.w};
#pragma unroll
      for (int i = 0; i < 8; ++i) { VT[(dq * 16 + 2 * i) * ST136 + s] = (bf16)(vv[i] & 0xffffu); VT[(dq * 16 + 2 * i + 1) * ST136 + s] = (bf16)(vv[i] >> 16); }
      const int d = tid >> 3, e0 = (tid & 7) * 8; const f32x4 r0 = *(const f32x4*)(ST + d * 64 + e0), r1 = *(const f32x4*)(ST + d * 64 + e0 + 4);
#pragma unroll
      for (int i = 0; i < 4; ++i) { RT[(e0 + i) * ST72 + d] = f2bf(r0[i]); RT[(e0 + 4 + i) * ST72 + d] = f2bf(r1[i]); } }
    __syncthreads();
    for (int blk = wid; blk < 10; blk += 8) {
        const int tb = blk < 1 ? 0 : blk < 3 ? 1 : blk < 6 ? 2 : 3, sb = blk - (tb * (tb + 1)) / 2; f32x16 acc = {};
#pragma unroll
        for (int ks = 0; ks < 4; ++ks) { const bf16x8 a = *(const bf16x8*)(Q + (32 * tb + r) * ST72 + 16 * ks + 8 * h); const bf16x8 bb = *(const bf16x8*)(K + (32 * sb + r) * ST72 + 16 * ks + 8 * h); acc = MFMA32(a, bb, acc); }
#pragma unroll
        for (int i = 0; i < 16; ++i) { const int t = 32 * tb + crow(i, h), s = 32 * sb + r; const float v = s <= t ? acc[i] * __builtin_amdgcn_exp2f((float)(t - s) * lg) : 0.f; Pm[t * ST136 + s] = f2bf(v); }
    }
    __syncthreads();
    const int tb = wid >> 1, eb = wid & 1; f32x16 a1 = {}, a2 = {};
    for (int ks = 0; ks < 2 * (tb + 1); ++ks) { const bf16x8 a = *(const bf16x8*)(Pm + (32 * tb + r) * ST136 + 16 * ks + 8 * h); const bf16x8 bb = *(const bf16x8*)(VT + (32 * eb + r) * ST136 + 16 * ks + 8 * h); a1 = MFMA32(a, bb, a1); }
#pragma unroll
    for (int ks = 0; ks < 4; ++ks) { const bf16x8 a = *(const bf16x8*)(Q + (32 * tb + r) * ST72 + 16 * ks + 8 * h); const bf16x8 bb = *(const bf16x8*)(RT + (32 * eb + r) * ST72 + 16 * ks + 8 * h); a2 = MFMA32(a, bb, a2); }
    __syncthreads();
#pragma unroll
    for (int i = 0; i < 16; ++i) { const int t = 32 * tb + crow(i, h); O[t * 65 + 32 * eb + r] = a1[i] + a2[i] * __builtin_amdgcn_exp2f((float)(t + 1) * lg); }
    __syncthreads();
    { const int t = tid >> 2, eq = tid & 3; float v[16]; float ss = 0.f;
#pragma unroll
      for (int i = 0; i < 16; ++i) { v[i] = O[t * 65 + eq * 16 + i]; ss += v[i] * v[i]; }
      ss += __shfl_xor(ss, 1); ss += __shfl_xor(ss, 2);
      const float rn = rsqrtf(ss * (1.0f / 64.0f) + EPS); const size_t row = row0 + t;
      const bf16* gp = Z + row * ZP + 1664 + hh * 64 + eq * 16; const u32x4 ga = *(const u32x4*)gp, gb = *(const u32x4*)(gp + 8);
      const unsigned gg[8] = {ga.x, ga.y, ga.z, ga.w, gb.x, gb.y, gb.z, gb.w}; unsigned ow[8];
#pragma unroll
      for (int i = 0; i < 8; ++i) { const float g0 = bflo(gg[i]), g1 = bfhi(gg[i]);
          ow[i] = pk2(g0 * pg8::sigmoid_f(g0) * v[2 * i] * rn, g1 * pg8::sigmoid_f(g1) * v[2 * i + 1] * rn); }
      bf16* op = MIX + row * 1024 + 256 + hh * 64 + eq * 16;
      *(u32x4*)op = (u32x4){ow[0], ow[1], ow[2], ow[3]}; *(u32x4*)(op + 8) = (u32x4){ow[4], ow[5], ow[6], ow[7]}; }
    __syncthreads();
}
DI void fox_unit(const Params& P, int b, int hh, int qb, char* lds) {
    int tid_u = threadIdx.x; asm volatile("" : "+v"(tid_u)); const int tid = tid_u, lane = tid & 63, wid = tid >> 6, r = lane & 31, h = lane >> 5;
    bf16* Kt = (bf16*)lds; bf16* VT = Kt + 2 * 64 * ST72; float* NC = (float*)(VT + 2 * 64 * ST68);
    const bf16* Z = (const bf16*)(P.ws + WS_RA); bf16* MIX = (bf16*)(P.ws + WS_RB);
    const size_t rowb = (size_t)b * S; const int q0 = qb * 256;
    const float* c2 = (const float*)(P.ws + WS_C2) + (size_t)(b * 6 + hh) * S; const float cref = c2[q0];
    const int qrow = q0 + 32 * wid + r;
    bf16x8 qf[4];
    { const bf16* qp = Z + (rowb + qrow) * ZP + 2048 + hh * 64; const float sc = 0.125f * LOG2E;
#pragma unroll
      for (int s = 0; s < 4; ++s) { const u32x4 w = *(const u32x4*)(qp + 16 * s + 8 * h); u32x4 o;
          o.x = pk2(bflo(w.x) * sc, bfhi(w.x) * sc); o.y = pk2(bflo(w.y) * sc, bfhi(w.y) * sc); o.z = pk2(bflo(w.z) * sc, bfhi(w.z) * sc); o.w = pk2(bflo(w.w) * sc, bfhi(w.w) * sc);
          qf[s] = __builtin_bit_cast(bf16x8, o); } }
    float qn;
    { float ss = 0.f;
#pragma unroll
      for (int s = 0; s < 4; ++s) { const u32x4 w = __builtin_bit_cast(u32x4, qf[s]);
          ss += bflo(w.x) * bflo(w.x) + bfhi(w.x) * bfhi(w.x) + bflo(w.y) * bflo(w.y) + bfhi(w.y) * bfhi(w.y) + bflo(w.z) * bflo(w.z) + bfhi(w.z) * bfhi(w.z) + bflo(w.w) * bflo(w.w) + bfhi(w.w) * bfhi(w.w); }
      ss += __shfl_xor(ss, 32);
#pragma unroll
      for (int o = 1; o < 32; o <<= 1) ss = fmaxf(ss, __shfl_xor(ss, o));
      qn = sqrtf(ss) * 1.001f; }
    const float* kpms = (const float*)(P.ws + WS_KPMS) + (b * 6 + hh) * NCH;
    volatile unsigned* dflag = (volatile unsigned*)(NC + 128);
    if (tid < 8) dflag[tid] = 0u;
    bool done = false;
    f32x16 o0 = {}, o1 = {}; float m = -INFINITY, l = 0.f;
    const int ntile = 4 * (qb + 1);
    const int lrow = tid >> 3, lch = tid & 7;
    const bf16* kg = Z + (rowb + lrow) * ZP + 2432 + hh * 64 + lch * 8; const bf16* vg = Z + (rowb + lrow) * ZP + 2816 + hh * 64 + lch * 8;
    u32x4 kreg, vreg; float ncreg = 0.f;
#define FOX_LOAD(t) do { kreg = *(const u32x4*)(kg + (size_t)(t) * 64 * ZP); vreg = *(const u32x4*)(vg + (size_t)(t) * 64 * ZP); if (tid < 64) ncreg = cref - c2[64 * (t) + tid]; } while (0)
#define FOX_STORE(bufi) do { *(u32x4*)(Kt + (bufi) * 64 * ST72 + lrow * ST72 + lch * 8) = kreg; bf16* vt_ = VT + (bufi) * 64 * ST68 + (lch * 8) * ST68 + lrow; \
        vt_[0] = (bf16)(vreg.x & 0xffffu); vt_[ST68] = (bf16)(vreg.x >> 16); vt_[2 * ST68] = (bf16)(vreg.y & 0xffffu); vt_[3 * ST68] = (bf16)(vreg.y >> 16); \
        vt_[4 * ST68] = (bf16)(vreg.z & 0xffffu); vt_[5 * ST68] = (bf16)(vreg.z >> 16); vt_[6 * ST68] = (bf16)(vreg.w & 0xffffu); vt_[7 * ST68] = (bf16)(vreg.w >> 16); \
        if (tid < 64) NC[(bufi) * 64 + tid] = ncreg; } while (0)
    FOX_LOAD(ntile - 1); FOX_STORE(0); __syncthreads();
    int buf = 0;
    for (int t = ntile - 1; t >= 0; --t) {
        float c2n = 0.f, kpn = 0.f;
        if (t > 0) { FOX_LOAD(t - 1); c2n = c2[64 * t - 1]; kpn = kpms[(t - 1) >> 1]; }
        const int kv0 = 64 * t;
        if (!done && kv0 <= q0 + 32 * wid + 31) {
            const bf16* Kb = Kt + buf * 64 * ST72; const bf16* Vb = VT + buf * 64 * ST68; const float* NCb = NC + buf * 64;
            f32x16 p0 = {}, p1 = {};
#pragma unroll
            for (int s = 0; s < 4; ++s) { const bf16x8 a0 = *(const bf16x8*)(Kb + r * ST72 + 16 * s + 8 * h), a1 = *(const bf16x8*)(Kb + (32 + r) * ST72 + 16 * s + 8 * h);
                p0 = MFMA32(a0, qf[s], p0); p1 = MFMA32(a1, qf[s], p1); }
#pragma unroll
            for (int g = 0; g < 4; ++g) { const f32x4 n0 = *(const f32x4*)(NCb + 8 * g + 4 * h), n1 = *(const f32x4*)(NCb + 32 + 8 * g + 4 * h);
#pragma unroll
                for (int j = 0; j < 4; ++j) { p0[4 * g + j] += n0[j]; p1[4 * g + j] += n1[j]; } }
            if (kv0 + 63 > q0 + 32 * wid) {
#pragma unroll
                for (int i = 0; i < 16; ++i) { const int kv = kv0 + crow(i, h); if (kv > qrow) p0[i] = -INFINITY; if (kv + 32 > qrow) p1[i] = -INFINITY; } }
            float mx = fmaxf(p0[0], p1[0]);
#pragma unroll
            for (int i = 1; i < 16; ++i) mx = fmaxf(mx, fmaxf(p0[i], p1[i]));
            mx = fmaxf(mx, __shfl_xor(mx, 32));
            const float mn = fmaxf(m, mx), mu = (mn == -INFINITY) ? 0.f : mn; const float alpha = __builtin_amdgcn_exp2f(m - mu); m = mn;
            float ls = 0.f;
#pragma unroll
            for (int i = 0; i < 16; ++i) { p0[i] = __builtin_amdgcn_exp2f(p0[i] - mu); p1[i] = __builtin_amdgcn_exp2f(p1[i] - mu); ls += p0[i] + p1[i]; }
            l = l * alpha + ls;
#pragma unroll
            for (int i = 0; i < 16; ++i) { o0[i] *= alpha; o1[i] *= alpha; }
#pragma unroll
            for (int blk = 0; blk < 2; ++blk)
#pragma unroll
                for (int s = 0; s < 2; ++s) { const bf16x8 pf = blk == 0 ? pack8(p0, 8 * s) : pack8(p1, 8 * s); const int kvo = 32 * blk + 16 * s + 4 * h;
                    const u32x2 l0 = *(const u32x2*)(Vb + r * ST68 + kvo), h0 = *(const u32x2*)(Vb + r * ST68 + kvo + 8);
                    const u32x2 l1 = *(const u32x2*)(Vb + (32 + r) * ST68 + kvo), h1 = *(const u32x2*)(Vb + (32 + r) * ST68 + kvo + 8);
                    const u32x4 v0 = {l0.x, l0.y, h0.x, h0.y}, v1 = {l1.x, l1.y, h1.x, h1.y};
                    o0 = MFMA32(__builtin_bit_cast(bf16x8, v0), pf, o0); o1 = MFMA32(__builtin_bit_cast(bf16x8, v1), pf, o1); }
            if (t > 0) { float mm = m;
#pragma unroll
                for (int o = 1; o < 32; o <<= 1) mm = fminf(mm, __shfl_xor(mm, o));
                const float mmu = __uint_as_float(__builtin_amdgcn_readfirstlane(__float_as_uint(mm)));
                if (qn * kpn + (cref - c2n) < mmu - 40.0f) done = true; }
        }
        if (t > 0) FOX_STORE(buf ^ 1);
        if (done && lane == 0) dflag[wid] = 1u;
        __syncthreads();
        buf ^= 1;
        if ((dflag[0] & dflag[1] & dflag[2] & dflag[3] & dflag[4] & dflag[5] & dflag[6] & dflag[7]) != 0u) break;
    }
#undef FOX_LOAD
#undef FOX_STORE
    l += __shfl_xor(l, 32); const float inv = 1.0f / l;
    bf16* op = MIX + (rowb + qrow) * 1024 + 640 + hh * 64;
#pragma unroll
    for (int g = 0; g < 4; ++g) { u32x2 w; w.x = pk2(o0[4 * g] * inv, o0[4 * g + 1] * inv); w.y = pk2(o0[4 * g + 2] * inv, o0[4 * g + 3] * inv); *(u32x2*)(op + 8 * g + 4 * h) = w;
        w.x = pk2(o1[4 * g] * inv, o1[4 * g + 1] * inv); w.y = pk2(o1[4 * g + 2] * inv, o1[4 * g + 3] * inv); *(u32x2*)(op + 32 + 8 * g + 4 * h) = w; }
}
#ifndef PMASK
#define PMASK 0xffff
#endif
#define PEN(k) ((PMASK >> (k)) & 1)
constexpr int LDS_BYTES = 147456;
constexpr int LDS_QW = 140 * 1024;
typedef const __attribute__((address_space(4))) Params* kparams_t;
#if defined(__HIP_DEVICE_COMPILE__)
#define PH_COPY const Params P = *pp_;
#else
#define PH_COPY const Params P = Pk; const Params* pp_h = &Pk; (void)pp_h;
#endif
#define PH_BEGIN  kparams_t pp_ = (kparams_t)__builtin_amdgcn_kernarg_segment_ptr(); asm volatile("" : "+s"(pp_)); PH_COPY \
    int tid_ = threadIdx.x; asm volatile("" : "+v"(tid_)); const int tid = tid_, lane = tid & 63, wave = __builtin_amdgcn_readfirstlane(tid >> 6); \
    const int G = gridDim.x, bx = blockIdx.x, gw = bx * 8 + wave, NGW = G * 8; unsigned char* ws = P.ws; (void)lane; (void)gw; (void)NGW; (void)ws; \
    PG8_LAS unsigned char* L = (PG8_LAS unsigned char*)lds; (void)L;
#define GRID_SYNC() do { asm volatile("s_waitcnt vmcnt(0) lgkmcnt(0)" ::: "memory"); grid.sync(); __builtin_amdgcn_fence(__ATOMIC_ACQUIRE, "agent"); asm volatile("s_waitcnt vmcnt(0)" ::: "memory"); } while (0)
#define WSP(T_, off) ((T_*)(ws + (off)))
__global__ void __launch_bounds__(512, 2) fwd_kernel(Params Pk) {
    extern __shared__ __attribute__((aligned(16))) unsigned char lds[];
    cg::grid_group grid = cg::this_grid();
    { PH_BEGIN
      convert_weights(P, 0, (char*)lds, gw, NGW, wave, lane);
      rope_table(P, bx * 512 + tid, G * 512);
      resid_rows(P, P.in[I_X], nullptr, nullptr, nullptr, gw, NGW, lane); }
    GRID_SYNC();
    for (int layer = 0; layer < DEPTH; ++layer) {
        if (PEN(1)) { PH_BEGIN
          pg8::Gemm g{WSP(bf16, WS_XB), WSP(const bf16, WS_W + W_IN), T, ZP, 1024}; pg8::StaticOrder So; So.init(T, ZP, G, bx);
          pg8::EpiZ E{WSP(bf16, WS_RA), WSP(float, WS_RINVX), WSP(float, WS_LF), P.in[I_FOXB] + layer * 6};
          pg8::gemm_phase<pg8::EpiZ, pg8::StaticOrder, true, true>(L, g, So, E); }
        GRID_SYNC();
        if (PEN(2)) { PH_BEGIN
          for (int u = bx; u < 1024 + 1536 + 256; u += G) {
            if (u < 1024) { sgu_unit(P, layer, u >> 9, (u >> 2) & 127, u & 3, (char*)lds); }
            else if (u < 2560) { const int v = u - 1024, bh = v / NCH, c = v % NCH; ret1_unit(P, pp_->lg2gam[bh % 6], bh / 6, bh % 6, c, (char*)lds); }
            else { const int v = u - 2560; cum_unit(P, v >> 7, v & 127); } } }
        GRID_SYNC();
        if (PEN(3)) { PH_BEGIN
          float* ST = (float*)(ws + WS_RB + 64 * MiB);
          for (int e = bx * 512 + tid; e < 12 * 4096; e += G * 512) { const int bh = e >> 12, de = e & 4095; const float g128 = __builtin_amdgcn_exp2f(128.0f * pp_->lg2gam[bh % 6]);
              float* p = ST + (size_t)bh * NCH * 4096 + de; float carry = 0.f;
#pragma unroll 8
              for (int c = 0; c < NCH; ++c) { const float s = p[(size_t)c * 4096]; p[(size_t)c * 4096] = carry; carry = carry * g128 + s; } }
          const float* CT = (const float*)(ws + WS_CT); const float* CL = (const float*)(ws + WS_CL); float* C2 = (float*)(ws + WS_C2);
          for (int u = bx; u < 12 * NCH; u += G) { const int bh = u / NCH, c = u % NCH;
              if (tid < 128) { const float* KN = (const float*)(ws + WS_KN); float pre = 0.f, kpm = KN[bh * NCH + c]; for (int cc = 0; cc < c; ++cc) { pre += CT[bh * NCH + cc]; kpm = fmaxf(kpm, KN[bh * NCH + cc]); }
                  const size_t i = (size_t)bh * S + (size_t)c * 128 + tid; C2[i] = (pre + CL[i]) * LOG2E;
                  if (tid == 0) ((float*)(ws + WS_KPMS))[bh * NCH + c] = sqrtf(kpm); } } }
        GRID_SYNC();
        if (PEN(4)) { PH_BEGIN
          unsigned* qctr = WSP(unsigned, WS_CTL) + 64 * (1 + layer); volatile unsigned* qw = (volatile unsigned*)(lds + LDS_QW);
          for (;;) { if (tid == 0) *qw = atomicAdd(qctr, 1u);
              __syncthreads(); const unsigned u = *qw; __syncthreads();
              if (u >= 768u + 1536u) break;
              if (u < 768u) { const int qb = 63 - (int)(u / 12u), bh = (int)(u % 12u); fox_unit(P, bh / 6, bh % 6, qb, (char*)lds); }
              else { const int v = (int)u - 768, bh = v / NCH, c = v % NCH; ret3_unit(P, pp_->lg2gam[bh % 6], bh / 6, bh % 6, c, (char*)lds); } } }
        GRID_SYNC();
        if (PEN(5)) { PH_BEGIN
          pg8::Gemm g{WSP(bf16, WS_RB), WSP(const bf16, WS_W + W_O), T, 1024, 1024}; pg8::StaticOrder So; So.init(T, 1024, G, bx);
          pg8::EpiY E{WSP(bf16, WS_RA), WSP(float, WS_SSQP), 1024}; pg8::gemm_phase<pg8::EpiY, pg8::StaticOrder, true, true>(L, g, So, E); }
        GRID_SYNC();
        { PH_BEGIN
          resid_rows(P, layer == 0 ? P.in[I_X] : P.out, P.out, WSP(bf16, WS_RA), P.in[I_MIXPOST] + layer * 1024, gw, NGW, lane); }
        GRID_SYNC();
        if (PEN(7)) for (int st = 0; st < 5; ++st) {
            if (st == 2 || st == 4) { PH_BEGIN
                const int hb = (st - 2) >> 1;
                pg8::Gemm g{WSP(bf16, WS_RA) + (size_t)S * DFF, WSP(const bf16, WS_W + W_D), S, 1024, DFF}; pg8::StaticOrder So; So.init(S, 1024, G, bx);
                pg8::EpiY E{WSP(bf16, WS_RB) + (size_t)hb * S * 1024, WSP(float, WS_SSQP) + (size_t)hb * S * 16, 1024}; pg8::gemm_phase<pg8::EpiY, pg8::StaticOrder, true, true>(L, g, So, E); }
            if (st == 0 || st == 2) { PH_BEGIN
                const int hb = st >> 1;
                pg8::Gemm g{WSP(bf16, WS_XB) + (size_t)hb * S * 1024, WSP(const bf16, WS_W + W_G), S, DFF, 1024}; pg8::StaticOrder So; So.init(S, DFF, G, bx);
                pg8::EpiS E{WSP(bf16, WS_RA), WSP(float, WS_RINVX) + hb * S, DFF}; pg8::gemm_phase<pg8::EpiS, pg8::StaticOrder, true, true>(L, g, So, E); }
            if (st == 1 || st == 3) { PH_BEGIN
                const int hb = st >> 1;
                pg8::Gemm g{WSP(bf16, WS_XB) + (size_t)hb * S * 1024, WSP(const bf16, WS_W + W_U), S, DFF, 1024}; pg8::StaticOrder So; So.init(S, DFF, G, bx);
                pg8::EpiAct E{WSP(bf16, WS_RA) + (size_t)S * DFF, WSP(const bf16, WS_RA), WSP(float, WS_RINVX) + hb * S, P.in[I_CONVW] + (size_t)layer * 3 * DFF, P.in[I_CONVB] + (size_t)layer * DFF};
                pg8::gemm_phase<pg8::EpiAct, pg8::StaticOrder, true, true>(L, g, So, E); }
            GRID_SYNC();
        }
        if (PEN(10)) { PH_BEGIN
          int kd_ = 256; asm volatile("" : "+s"(kd_));
          pg8::Gemm g{WSP(const bf16, WS_PB), WSP(const bf16, WS_W + W_PP), T, 1024, kd_}; pg8::StaticOrder So; So.init(T, 1024, G, bx);
          pg8::EpiS E{WSP(bf16, WS_RA), nullptr, 1024}; pg8::gemm_phase<pg8::EpiS, pg8::StaticOrder, true, true>(L, g, So, E); }
        { PH_BEGIN
          resid_rows(P, P.out, P.out, WSP(bf16, WS_RB), P.in[I_FFNPOST] + layer * 1024, gw, NGW, lane); }
        GRID_SYNC();
        if (PEN(11)) { PH_BEGIN
          pg8::Gemm g{WSP(bf16, WS_XB), WSP(const bf16, WS_W + W_PG), T, 1024, 1024}; pg8::StaticOrder So; So.init(T, 1024, G, bx);
          pg8::EpiPle E{WSP(bf16, WS_RB), WSP(const bf16, WS_RA), WSP(float, WS_RINVX), WSP(float, WS_SSQP)}; pg8::gemm_phase<pg8::EpiPle, pg8::StaticOrder, true, true>(L, g, So, E); }
        GRID_SYNC();
        { PH_BEGIN
          resid_rows(P, P.out, P.out, WSP(bf16, WS_RB), P.in[I_PLEPOST] + layer * 1024, gw, NGW, lane);
          if (layer + 1 < DEPTH) { __syncthreads(); convert_weights(P, layer + 1, (char*)lds, gw, NGW, wave, lane); } }
        if (layer + 1 < DEPTH) GRID_SYNC();
    }
}

extern "C" void kernel_launch(void* const* d_in, const int* in_sizes, int n_in, void* d_out, int out_size, void* d_ws, size_t ws_size, hipStream_t stream) {
    static int grid = 0;
    if (grid == 0) {
        if (n_in != N_INPUTS || ws_size < WS_END) { fprintf(stderr, "kernel_launch: unexpected n_in %d / ws_size %zu\n", n_in, ws_size); grid = -1; return; }
        int dev = 0, cus = 0, per_cu = 0;
        (void)hipGetDevice(&dev); (void)hipDeviceGetAttribute(&cus, hipDeviceAttributeMultiprocessorCount, dev);
        (void)hipFuncSetAttribute((const void*)fwd_kernel, hipFuncAttributeMaxDynamicSharedMemorySize, LDS_BYTES);
        (void)hipOccupancyMaxActiveBlocksPerMultiprocessor(&per_cu, (const void*)fwd_kernel, 512, LDS_BYTES);
        if (per_cu < 1) { fprintf(stderr, "kernel_launch: occupancy query says %d blocks/CU\n", per_cu); per_cu = 1; }
        grid = cus;
    }
    if (grid < 0) return;
    (void)hipMemsetAsync((char*)d_ws + WS_CTL, 0, 4096, stream);
    Params p; memset(&p, 0, sizeof(p));
    for (int i = 0; i < N_INPUTS; ++i) p.in[i] = (const float*)d_in[i];
    p.out = (float*)d_out; p.ws = (unsigned char*)d_ws;
    for (int h = 0; h < 6; ++h) p.lg2gam[h] = (float)log2(1.0 - exp2(-5.0 - (double)h));
    void* args[] = {&p};
    hipError_t e = hipLaunchCooperativeKernel((const void*)fwd_kernel, dim3(grid), dim3(512), args, LDS_BYTES, stream);
    if (e != hipSuccess) fprintf(stderr, "cooperative launch failed: %s (grid %d)\n", hipGetErrorString(e), grid);
}
```

```cpp
#include <hip/hip_runtime.h>
#include <hip/hip_cooperative_groups.h>
#include <cstdio>
#include <cstdint>
#include <cmath>
#include <cstring>
namespace cg = cooperative_groups;
namespace pg8 {
#define PG8_LAS __attribute__((address_space(3)))
typedef unsigned short bf16_t;
typedef short bf16x8 __attribute__((ext_vector_type(8)));
typedef float f32x4 __attribute__((ext_vector_type(4)));
typedef unsigned u32x4 __attribute__((ext_vector_type(4)));
constexpr int BM = 256, BK = 64, HALF = 128, HTB = HALF * BK * 2  , STAGE_BYTES = 8 * HTB, NXCD = 8, WGM = 8;

__host__ __device__ __forceinline__ int lds_byte(int r, int c) { const int st = (r >> 4) * 2 + (c >> 5), rr = r & 15, cc = c & 31, ob = rr * 64 + cc * 2; return st * 1024 + (ob ^ (((ob >> 9) & 1) << 5)); }
__host__ __device__ __forceinline__ void stage_rc(int b, int& R, int& C) { const int st = b / 1024, sb = b % 1024, swz = sb ^ (((sb >> 9) & 1) << 5); R = (st >> 1) * 16 + swz / 64; C = (st & 1) * 32 + (swz % 64) / 2; }
__host__ __device__ __forceinline__ int perm32(int rho) { const int n = rho >> 4, i = rho & 15; return 8 * (i >> 2) + 4 * n + (i & 3); }

struct Unit { int pm, pn; };
struct Gemm { const bf16_t* A; const bf16_t* Bt; int M, N, K; };

struct StaticOrder {
    int nM, nN, nwg, G, c;
    __host__ __device__ void init(int M, int N, int G_, int c_) { nM = M / BM; nN = N / BM; nwg = nM * nN; G = G_; c = c_; }
    __host__ __device__ bool next(int i, Unit& u) const {
        const long L = (long)i * G + c; if (L >= nwg) return false;
        int wgid = (int)L; { const int q = nwg / NXCD, r = nwg % NXCD, xcd = wgid % NXCD, off = wgid / NXCD; wgid = (xcd < r ? xcd * (q + 1) : r * (q + 1) + (xcd - r) * q) + off; }
        const int nig = WGM * nN, gid = wgid / nig, fm = gid * WGM, gsz = (nM - fm) < WGM ? (nM - fm) : WGM;
        u.pm = fm + ((wgid % nig) % gsz); u.pn = (wgid % nig) / gsz; return true;
    }
    __device__ __forceinline__ void a_ready(const Unit&) const {}
    __device__ __forceinline__ void done(const Unit&) const {}
};

__device__ __forceinline__ unsigned cvt_pk_bf16(float lo, float hi) { unsigned r; asm volatile("v_cvt_pk_bf16_f32 %0, %1, %2" : "=v"(r) : "v"(lo), "v"(hi)); return r; }
typedef float f32x2 __attribute__((ext_vector_type(2)));
__device__ __forceinline__ f32x2 gelu_pk(f32x2 v) {
    const f32x2 av = __builtin_elementwise_abs(v), d = av * 0.2316418882f + 1.0f;
    f32x2 t; t.x = __builtin_amdgcn_rcpf(d.x); t.y = __builtin_amdgcn_rcpf(d.y);
    f32x2 q = t * 0.5307027145f + (-0.7265760135f); q = q * t + 0.7107068705f; q = q * t + (-0.142248368f); q = q * t + 0.127414796f; q = q * t;
    const f32x2 s = (v * v) * (-0.72134752044f);
    f32x2 e; e.x = __builtin_amdgcn_exp2f(s.x); e.y = __builtin_amdgcn_exp2f(s.y);
    const f32x2 m = v * (q * e), r = v - m;
    f32x2 o; o.x = v.x < 0.f ? m.x : r.x; o.y = v.y < 0.f ? m.y : r.y; return o;
}

template <int ACT  > struct EpiBf16 {
    static constexpr bool PERM = true, AFTER_DRAIN = false; static_assert(ACT == 0 || ACT == 1, "EpiBf16: ACT is 0 (none) or 1 (gelu_pk)");
    bf16_t* O; int ldc; const float* bias; int split_cols; size_t split_stride; float scale0;
    __device__ __forceinline__ void operator()(const f32x4 (&acc)[2][2][4][2], const Unit& u, int wr, int wc, int fr, int fq) const {
        const int row0 = u.pm * BM + wr * 64 + fr; int colt = u.pn * BM; bf16_t* base = O;
        float sc = 1.f; if (split_cols) { const int t = colt / split_cols; base += (size_t)t * split_stride; colt -= t * split_cols; if (t == 0) sc = scale0; }
        const int col0 = colt + wc * 32 + 8 * fq, bcol0 = u.pn * BM + wc * 32 + 8 * fq;
        f32x4 bv[2][2];
#pragma unroll
        for (int bj = 0; bj < 2; ++bj)
#pragma unroll
            for (int n = 0; n < 2; ++n) bv[bj][n] = bias ? *(const f32x4*)(bias + bcol0 + bj * HALF + 4 * n) : (f32x4){0.f, 0.f, 0.f, 0.f};
#pragma unroll
        for (int ai = 0; ai < 2; ++ai)
#pragma unroll
            for (int m = 0; m < 4; ++m) { bf16_t* rowp = base + (size_t)(row0 + ai * HALF + m * 16) * ldc + col0;
#pragma unroll
                for (int bj = 0; bj < 2; ++bj) { f32x4 v0 = acc[ai][bj][m][0] + bv[bj][0], v1 = acc[ai][bj][m][1] + bv[bj][1];
                    if (ACT == 1) { f32x2 a = gelu_pk((f32x2){v0[0], v0[1]}), b = gelu_pk((f32x2){v0[2], v0[3]}), c = gelu_pk((f32x2){v1[0], v1[1]}), d = gelu_pk((f32x2){v1[2], v1[3]});
                        v0 = (f32x4){a.x, a.y, b.x, b.y}; v1 = (f32x4){c.x, c.y, d.x, d.y}; }
                    v0 = v0 * sc; v1 = v1 * sc; u32x4 w; w.x = cvt_pk_bf16(v0[0], v0[1]); w.y = cvt_pk_bf16(v0[2], v0[3]); w.z = cvt_pk_bf16(v1[0], v1[1]); w.w = cvt_pk_bf16(v1[2], v1[3]);
                    *(u32x4*)(rowp + bj * HALF) = w; } }
    }
};

typedef float f32x2_t __attribute__((ext_vector_type(2))); typedef __bf16 bf16x2_t __attribute__((ext_vector_type(2)));
__device__ __forceinline__ unsigned pk2(float lo, float hi) { f32x2_t v = {lo, hi}; bf16x2_t b = __builtin_convertvector(v, bf16x2_t); return __builtin_bit_cast(unsigned, b); }
__device__ __forceinline__ float bflo(unsigned w) { return __uint_as_float(w << 16); }
__device__ __forceinline__ float bfhi(unsigned w) { return __uint_as_float(w & 0xffff0000u); }
__device__ __forceinline__ float gelu_tanh(float x) { const float t = x * (1.0f + 0.044715f * x * x); return x * __builtin_amdgcn_rcpf(1.0f + __builtin_amdgcn_exp2f(-2.3022082f * t)); }
__device__ __forceinline__ float sigmoid_f(float x) { return __builtin_amdgcn_rcpf(1.0f + __builtin_amdgcn_exp2f(-1.4426950409f * x)); }
__device__ __forceinline__ float logsigmoid_f(float x) { return fminf(x, 0.f) - log1pf(__expf(-fabsf(x))); }
constexpr int ZP = 3328;
struct EpiZ {
    static constexpr bool PERM = true, AFTER_DRAIN = false;
    bf16_t* Z; const float* rinv; float* LF; const float* bfv;
    __device__ __forceinline__ void operator()(const f32x4 (&acc)[2][2][4][2], const Unit& u, int wr, int wc, int fr, int fq) const {
        const int row0 = u.pm * BM + wr * 64 + fr, colb = u.pn * BM + wc * 32 + 8 * fq; const bool dog = u.pn < 2; const bool dof = (u.pn == 12) && (wc == 0) && (fq == 0);
#pragma unroll
        for (int ai = 0; ai < 2; ++ai)
#pragma unroll
            for (int m = 0; m < 4; ++m) { const int row = row0 + ai * HALF + m * 16; const float sc = rinv[row]; bf16_t* rowp = Z + (size_t)row * ZP + colb;
#pragma unroll
                for (int bj = 0; bj < 2; ++bj) { f32x4 v0 = acc[ai][bj][m][0] * sc, v1 = acc[ai][bj][m][1] * sc;
                    if (dog) { v0[0] = gelu_tanh(v0[0]); v0[1] = gelu_tanh(v0[1]); v0[2] = gelu_tanh(v0[2]); v0[3] = gelu_tanh(v0[3]); v1[0] = gelu_tanh(v1[0]); v1[1] = gelu_tanh(v1[1]); v1[2] = gelu_tanh(v1[2]); v1[3] = gelu_tanh(v1[3]); }
                    u32x4 w; w.x = pk2(v0[0], v0[1]); w.y = pk2(v0[2], v0[3]); w.z = pk2(v1[0], v1[1]); w.w = pk2(v1[2], v1[3]);
                    *(u32x4*)(rowp + bj * HALF) = w;
                    if (bj == 1 && dof) { float* lf = LF + (size_t)row * 8;
                        lf[0] = logsigmoid_f(v0[0] + bfv[0]); lf[1] = logsigmoid_f(v0[1] + bfv[1]); lf[2] = logsigmoid_f(v0[2] + bfv[2]); lf[3] = logsigmoid_f(v0[3] + bfv[3]);
                        lf[4] = logsigmoid_f(v1[0] + bfv[4]); lf[5] = logsigmoid_f(v1[1] + bfv[5]); } } }
    }
};
struct EpiY {
    static constexpr bool PERM = true, AFTER_DRAIN = false;
    bf16_t* Y; float* ssq; int ldc;
    __device__ __forceinline__ void operator()(const f32x4 (&acc)[2][2][4][2], const Unit& u, int wr, int wc, int fr, int fq) const {
        const int row0 = u.pm * BM + wr * 64 + fr, colb = u.pn * BM + wc * 32 + 8 * fq;
#pragma unroll
        for (int ai = 0; ai < 2; ++ai)
#pragma unroll
            for (int m = 0; m < 4; ++m) { const int row = row0 + ai * HALF + m * 16; bf16_t* rowp = Y + (size_t)row * ldc + colb; float ss = 0.f;
#pragma unroll
                for (int bj = 0; bj < 2; ++bj) { const f32x4 v0 = acc[ai][bj][m][0], v1 = acc[ai][bj][m][1];
                    ss += (v0[0] * v0[0] + v0[1] * v0[1]) + (v0[2] * v0[2] + v0[3] * v0[3]) + (v1[0] * v1[0] + v1[1] * v1[1]) + (v1[2] * v1[2] + v1[3] * v1[3]);
                    u32x4 w; w.x = pk2(v0[0], v0[1]); w.y = pk2(v0[2], v0[3]); w.z = pk2(v1[0], v1[1]); w.w = pk2(v1[2], v1[3]);
                    *(u32x4*)(rowp + bj * HALF) = w; }
                ss += __shfl_xor(ss, 16); ss += __shfl_xor(ss, 32);
                if (fq == 0) ssq[(size_t)row * 16 + (u.pn & 3) * 4 + wc] = ss; }
    }
};
struct EpiS {
    static constexpr bool PERM = true, AFTER_DRAIN = false;
    bf16_t* O; const float* rinv; int ldc;
    __device__ __forceinline__ void operator()(const f32x4 (&acc)[2][2][4][2], const Unit& u, int wr, int wc, int fr, int fq) const {
        const int row0 = u.pm * BM + wr * 64 + fr, colb = u.pn * BM + wc * 32 + 8 * fq;
#pragma unroll
        for (int ai = 0; ai < 2; ++ai)
#pragma unroll
            for (int m = 0; m < 4; ++m) { const int row = row0 + ai * HALF + m * 16; const float sc = rinv ? rinv[row] : 1.0f; bf16_t* rowp = O + (size_t)row * ldc + colb;
#pragma unroll
                for (int bj = 0; bj < 2; ++bj) { const f32x4 v0 = acc[ai][bj][m][0] * sc, v1 = acc[ai][bj][m][1] * sc;
                    u32x4 w; w.x = pk2(v0[0], v0[1]); w.y = pk2(v0[2], v0[3]); w.z = pk2(v1[0], v1[1]); w.w = pk2(v1[2], v1[3]);
                    *(u32x4*)(rowp + bj * HALF) = w; } }
    }
};
struct EpiAct {
    static constexpr bool PERM = true, AFTER_DRAIN = false;
    bf16_t* ACT; const bf16_t* G; const float* rinv; const float* cw; const float* cb;
    __device__ __forceinline__ void operator()(const f32x4 (&acc)[2][2][4][2], const Unit& u, int wr, int wc, int fr, int fq) const {
        const int row0 = u.pm * BM + wr * 64 + fr, colb = u.pn * BM + wc * 32 + 8 * fq;
#pragma unroll
        for (int bj = 0; bj < 2; ++bj) { const int col = colb + bj * HALF;
            float w0[8], w1[8], w2[8], b0[8];
#pragma unroll
            for (int j = 0; j < 2; ++j) { const f32x4 a = *(const f32x4*)(cw + col + 4 * j), b = *(const f32x4*)(cw + 4096 + col + 4 * j), c = *(const f32x4*)(cw + 8192 + col + 4 * j), d = *(const f32x4*)(cb + col + 4 * j);
#pragma unroll
                for (int k = 0; k < 4; ++k) { w0[4 * j + k] = a[k]; w1[4 * j + k] = b[k]; w2[4 * j + k] = c[k]; b0[4 * j + k] = d[k]; } }
#pragma unroll
            for (int ai = 0; ai < 2; ++ai)
#pragma unroll
                for (int m = 0; m < 4; ++m) { const int row = row0 + ai * HALF + m * 16; const float sc = rinv[row];
                    const bf16_t* gp = G + (size_t)row * 4096 + col; const u32x4 z4 = {0u, 0u, 0u, 0u};
                    const u32x4 g2 = *(const u32x4*)gp; const u32x4 g1 = row >= 1 ? *(const u32x4*)(gp - 4096) : z4; const u32x4 g0 = row >= 2 ? *(const u32x4*)(gp - 8192) : z4;
                    float o[8];
#pragma unroll
                    for (int k = 0; k < 4; ++k) { const unsigned a = g0[k], b = g1[k], c = g2[k];
                        const float c0 = b0[2 * k] + w0[2 * k] * bflo(a) + w1[2 * k] * bflo(b) + w2[2 * k] * bflo(c);
                        const float c1 = b0[2 * k + 1] + w0[2 * k + 1] * bfhi(a) + w1[2 * k + 1] * bfhi(b) + w2[2 * k + 1] * bfhi(c);
                        const float u0 = (k < 2 ? acc[ai][bj][m][0][2 * k] : acc[ai][bj][m][1][2 * k - 4]) * sc, u1 = (k < 2 ? acc[ai][bj][m][0][2 * k + 1] : acc[ai][bj][m][1][2 * k - 3]) * sc;
                        o[2 * k] = gelu_tanh(c0) * u0; o[2 * k + 1] = gelu_tanh(c1) * u1; }
                    u32x4 w; w.x = pk2(o[0], o[1]); w.y = pk2(o[2], o[3]); w.z = pk2(o[4], o[5]); w.w = pk2(o[6], o[7]);
                    *(u32x4*)(ACT + (size_t)row * 4096 + col) = w; } }
    }
};
struct EpiPle {
    static constexpr bool PERM = true, AFTER_DRAIN = false;
    bf16_t* Y; const bf16_t* E; const float* rinv; float* ssq;
    __device__ __forceinline__ void operator()(const f32x4 (&acc)[2][2][4][2], const Unit& u, int wr, int wc, int fr, int fq) const {
        const int row0 = u.pm * BM + wr * 64 + fr, colb = u.pn * BM + wc * 32 + 8 * fq;
#pragma unroll
        for (int ai = 0; ai < 2; ++ai)
#pragma unroll
            for (int m = 0; m < 4; ++m) { const int row = row0 + ai * HALF + m * 16; const float sc = rinv[row]; float ss = 0.f;
#pragma unroll
                for (int bj = 0; bj < 2; ++bj) { const size_t off = (size_t)row * 1024 + colb + bj * HALF; const u32x4 e = *(const u32x4*)(E + off);
                    const f32x4 v0 = acc[ai][bj][m][0] * sc, v1 = acc[ai][bj][m][1] * sc; float o[8];
                    o[0] = bflo(e.x) * sigmoid_f(v0[0]); o[1] = bfhi(e.x) * sigmoid_f(v0[1]); o[2] = bflo(e.y) * sigmoid_f(v0[2]); o[3] = bfhi(e.y) * sigmoid_f(v0[3]);
                    o[4] = bflo(e.z) * sigmoid_f(v1[0]); o[5] = bfhi(e.z) * sigmoid_f(v1[1]); o[6] = bflo(e.w) * sigmoid_f(v1[2]); o[7] = bfhi(e.w) * sigmoid_f(v1[3]);
#pragma unroll
                    for (int k = 0; k < 8; ++k) ss += o[k] * o[k];
                    u32x4 w; w.x = pk2(o[0], o[1]); w.y = pk2(o[2], o[3]); w.z = pk2(o[4], o[5]); w.w = pk2(o[6], o[7]);
                    *(u32x4*)(Y + off) = w; }
                ss += __shfl_xor(ss, 16); ss += __shfl_xor(ss, 32);
                if (fq == 0) ssq[(size_t)row * 16 + (u.pn & 3) * 4 + wc] = ss; }
    }
};
template <class Epi, class Sched, bool ALIGN_EPI = false, bool SP2 = false>
__device__ __forceinline__ void gemm_phase(PG8_LAS unsigned char* lds, const Gemm g, const Sched& S, const Epi& E) {
    int tid_o = threadIdx.x; asm volatile("" : "+v"(tid_o));
    const int tid = tid_o, wid = __builtin_amdgcn_readfirstlane(tid >> 6), lane = tid & 63, wr = wid >> 2, wc = wid & 3, fr = lane & 15, fq = lane >> 4;
    const int K = g.K, nt = K / BK;
    unsigned voffA[2], voffB[2];
#pragma unroll
    for (int i = 0; i < 2; ++i) { int R, C; stage_rc(tid * 16 + i * 8192, R, C); const int Rb = Epi::PERM ? ((R & ~31) + perm32(R & 31)) : R;
        voffA[i] = (unsigned)(R * K + C) * 2u; voffB[i] = (unsigned)(Rb * K + C) * 2u; }
    const size_t kstep = (size_t)(BK * 2);
    const size_t hstep = (size_t)HALF * K * 2;
    const size_t tstep = 2 * hstep;
    const unsigned ldsw = (unsigned)wid * 1024u;
    const int aoff = lds_byte(wr * 64 + fr, fq * 8), boff = lds_byte(wc * 32 + fr, fq * 8);
#define PG8_SA(b, h) (((b) * 2 + (h)) * HTB)
#define PG8_SB(b, h) ((4 + (b) * 2 + (h)) * HTB)
#define PG8_STAGE(bufoff, gbase, voff) do { _Pragma("unroll") for (int _i = 0; _i < 2; ++_i) \
        __builtin_amdgcn_global_load_lds((const unsigned*)((const char*)(gbase) + (voff)[_i]), (PG8_LAS unsigned*)(lds + (bufoff) + ldsw + _i * 8192), 16, 0, 0); } while (0)
#define PG8_LDA(dst, b, h) do { _Pragma("unroll") for (int m = 0; m < 4; ++m) _Pragma("unroll") for (int k = 0; k < 2; ++k) dst[m][k] = *(const PG8_LAS bf16x8*)(lds + PG8_SA(b, h) + aoff + m * 2048 + k * 1024); } while (0)
#define PG8_LDB(dst, b, h) do { _Pragma("unroll") for (int n = 0; n < 2; ++n) _Pragma("unroll") for (int k = 0; k < 2; ++k) dst[n][k] = *(const PG8_LAS bf16x8*)(lds + PG8_SB(b, h) + boff + n * 2048 + k * 1024); } while (0)
#define PG8_MMA(ai, bj, At, Bt) do { __builtin_amdgcn_s_setprio(1); _Pragma("unroll") for (int m = 0; m < 4; ++m) _Pragma("unroll") for (int n = 0; n < 2; ++n) _Pragma("unroll") for (int k = 0; k < 2; ++k) \
        acc[ai][bj][m][n] = __builtin_amdgcn_mfma_f32_16x16x32_bf16(Bt[n][k], At[m][k], acc[ai][bj][m][n], 0, 0, 0); __builtin_amdgcn_s_setprio(0); } while (0)
#define PG8_WAIT_V(n) asm volatile("s_waitcnt vmcnt(" #n ")" ::: "memory")
#define PG8_WAIT_L(n) asm volatile("s_waitcnt lgkmcnt(" #n ")" ::: "memory")
#define PG8_BAR __builtin_amdgcn_s_barrier()
#define PG8_SCHED __builtin_amdgcn_sched_barrier(0)
    Unit cur, nxt; int ui = 0;
    if (!S.next(0, cur)) return;
    f32x4 acc[2][2][4][2];
#pragma unroll
    for (int a = 0; a < 2; ++a)
#pragma unroll
        for (int b = 0; b < 2; ++b)
#pragma unroll
            for (int m = 0; m < 4; ++m)
#pragma unroll
                for (int n = 0; n < 2; ++n) acc[a][b][m][n] = (f32x4){0.f, 0.f, 0.f, 0.f};
    bf16x8 At[4][2], B0[2][2], B1[2][2];
    const char* cA = (const char*)g.A + (size_t)cur.pm * tstep; const char* cB = (const char*)g.Bt + (size_t)cur.pn * tstep;
    S.a_ready(cur);
    if constexpr (SP2) {
        PG8_STAGE(PG8_SB(0, 0), cB, voffB); PG8_STAGE(PG8_SB(0, 1), cB + hstep, voffB); PG8_STAGE(PG8_SA(0, 0), cA, voffA); PG8_STAGE(PG8_SA(0, 1), cA + hstep, voffA);
        if (wr == 1) PG8_BAR;
        PG8_WAIT_V(2); PG8_BAR;
        PG8_STAGE(PG8_SB(1, 0), cB + kstep, voffB); PG8_STAGE(PG8_SA(1, 0), cA + kstep, voffA); PG8_STAGE(PG8_SB(1, 1), cB + hstep + kstep, voffB);
        PG8_WAIT_V(6); PG8_BAR;
    } else {
        PG8_STAGE(PG8_SB(0, 0), cB, voffB); PG8_STAGE(PG8_SA(0, 0), cA, voffA); PG8_STAGE(PG8_SB(0, 1), cB + hstep, voffB); PG8_STAGE(PG8_SA(0, 1), cA + hstep, voffA);
        if (wr == 1) PG8_BAR;
        PG8_WAIT_V(4); PG8_BAR;
        PG8_STAGE(PG8_SB(1, 0), cB + kstep, voffB); PG8_STAGE(PG8_SA(1, 0), cA + kstep, voffA); PG8_STAGE(PG8_SB(1, 1), cB + hstep + kstep, voffB);
        PG8_WAIT_V(6); PG8_BAR;
    }
    for (;;) {
        const bool has_next = S.next(ui + 1, nxt);
        const char* nA = has_next ? (const char*)g.A + (size_t)nxt.pm * tstep : cA; const char* nB = has_next ? (const char*)g.Bt + (size_t)nxt.pn * tstep : cB;
        for (int t = 0; t < nt; t += 2) {
            const bool last = (t == nt - 2);
            const char* a1 = cA + (size_t)(t + 1) * kstep;
            const char* a2 = last ? nA : cA + (size_t)(t + 2) * kstep; const char* b2 = last ? nB : cB + (size_t)(t + 2) * kstep;
            const char* a3 = a2 + kstep; const char* b3 = b2 + kstep;
            if (last && has_next) S.a_ready(nxt);
            if constexpr (SP2) {
            PG8_LDB(B0, 0, 0); PG8_LDB(B1, 0, 1); PG8_SCHED; PG8_LDA(At, 0, 0); PG8_STAGE(PG8_SA(1, 1), a1 + hstep, voffA);
            PG8_WAIT_V(8); PG8_WAIT_L(0); PG8_BAR; PG8_MMA(0, 0, At, B0); PG8_MMA(0, 1, At, B1); PG8_BAR; PG8_SCHED;
            PG8_LDA(At, 0, 1); PG8_STAGE(PG8_SB(0, 0), b2, voffB); PG8_STAGE(PG8_SB(0, 1), b2 + hstep, voffB); PG8_STAGE(PG8_SA(0, 0), a2, voffA);
            PG8_WAIT_V(8); PG8_WAIT_L(0); PG8_BAR; PG8_MMA(1, 0, At, B0); PG8_MMA(1, 1, At, B1); PG8_BAR; PG8_SCHED;
            PG8_LDB(B0, 1, 0); PG8_LDB(B1, 1, 1); PG8_SCHED; PG8_LDA(At, 1, 0); PG8_STAGE(PG8_SA(0, 1), a2 + hstep, voffA);
            PG8_WAIT_V(8); PG8_WAIT_L(0); PG8_BAR; PG8_MMA(0, 0, At, B0); PG8_MMA(0, 1, At, B1); PG8_BAR; PG8_SCHED;
            PG8_LDA(At, 1, 1); PG8_STAGE(PG8_SB(1, 0), b3, voffB); PG8_STAGE(PG8_SB(1, 1), b3 + hstep, voffB); PG8_STAGE(PG8_SA(1, 0), a3, voffA);
            PG8_WAIT_V(8); PG8_WAIT_L(0); PG8_BAR; PG8_MMA(1, 0, At, B0); PG8_MMA(1, 1, At, B1); PG8_BAR; PG8_SCHED;
            } else {
            PG8_LDB(B0, 0, 0); PG8_SCHED; PG8_LDA(At, 0, 0); PG8_STAGE(PG8_SA(1, 1), a1 + hstep, voffA);
            PG8_WAIT_L(8); PG8_BAR; PG8_WAIT_L(0); PG8_MMA(0, 0, At, B0); PG8_BAR; PG8_SCHED;
            PG8_LDB(B1, 0, 1); PG8_STAGE(PG8_SB(0, 0), b2, voffB);
            PG8_BAR; PG8_WAIT_L(0); PG8_MMA(0, 1, At, B1); PG8_BAR;
            PG8_LDA(At, 0, 1); PG8_STAGE(PG8_SA(0, 0), a2, voffA);
            PG8_BAR; PG8_WAIT_L(0); PG8_MMA(1, 0, At, B0); PG8_BAR; PG8_SCHED;
            PG8_STAGE(PG8_SB(0, 1), b2 + hstep, voffB);
            PG8_WAIT_V(6); PG8_BAR; PG8_MMA(1, 1, At, B1); PG8_BAR;
            PG8_LDB(B0, 1, 0); PG8_SCHED; PG8_LDA(At, 1, 0); PG8_STAGE(PG8_SA(0, 1), a2 + hstep, voffA);
            PG8_WAIT_L(8); PG8_BAR; PG8_WAIT_L(0); PG8_MMA(0, 0, At, B0); PG8_BAR; PG8_SCHED;
            PG8_LDB(B1, 1, 1); PG8_STAGE(PG8_SB(1, 0), b3, voffB);
            PG8_BAR; PG8_WAIT_L(0); PG8_MMA(0, 1, At, B1); PG8_BAR;
            PG8_LDA(At, 1, 1); PG8_STAGE(PG8_SA(1, 0), a3, voffA);
            PG8_BAR; PG8_WAIT_L(0); PG8_MMA(1, 0, At, B0); PG8_BAR; PG8_SCHED;
            PG8_STAGE(PG8_SB(1, 1), b3 + hstep, voffB);
            PG8_WAIT_V(6); PG8_BAR; PG8_MMA(1, 1, At, B1); PG8_BAR;
            }
        }
        if constexpr (ALIGN_EPI) { if (wr == 0) PG8_BAR; }
        if constexpr (!Epi::AFTER_DRAIN) { E(acc, cur, wr, wc, fr, fq); S.done(cur); }
        if (!has_next) break;
#pragma unroll
        for (int a = 0; a < 2; ++a)
#pragma unroll
            for (int b = 0; b < 2; ++b)
#pragma unroll
                for (int m = 0; m < 4; ++m)
#pragma unroll
                    for (int n = 0; n < 2; ++n) acc[a][b][m][n] = (f32x4){0.f, 0.f, 0.f, 0.f};
        cur = nxt; cA = nA; cB = nB; ++ui;
        if constexpr (ALIGN_EPI) { if (wr == 1) PG8_BAR; }
    }
    PG8_WAIT_V(0);
    if constexpr (!ALIGN_EPI) { if (wr == 0) PG8_BAR; }
    PG8_BAR;
    if constexpr (Epi::AFTER_DRAIN) { E.fused(acc, cur, wr, wc, fr, fq, lds, wid, lane); S.done(cur); }
#undef PG8_SA
#undef PG8_SB
#undef PG8_STAGE
#undef PG8_LDA
#undef PG8_LDB
#undef PG8_MMA
#undef PG8_WAIT_V
#undef PG8_WAIT_L
#undef PG8_BAR
#undef PG8_SCHED
}
}
#define DI __device__ __forceinline__
typedef unsigned short bf16;
typedef short bf16x8 __attribute__((ext_vector_type(8)));
typedef float f32x4 __attribute__((ext_vector_type(4)));
typedef float f32x16 __attribute__((ext_vector_type(16)));
typedef unsigned u32x4 __attribute__((ext_vector_type(4)));
typedef unsigned u32x2 __attribute__((ext_vector_type(2)));
using pg8::pk2; using pg8::bflo; using pg8::bfhi; using pg8::ZP;
#define MFMA32(a, b, c) __builtin_amdgcn_mfma_f32_32x32x16_bf16((a), (b), (c), 0, 0, 0)
constexpr int NB = 2, S = 16384, T = NB * S, DM = 1024, DEPTH = 2, DFF = 4096, NIN = 3206;
constexpr float EPS = 1e-6f, LOG2E = 1.4426950408889634f;
constexpr int NCH = S / 128;
enum { I_X = 0, I_P, I_POS, I_MIXPRE, I_WIN, I_SGUVG, I_SGUW, I_SGUB, I_FOXB, I_WO, I_MIXPOST, I_FFNPRE, I_WGATE, I_WUP, I_CONVW, I_CONVB, I_WDOWN, I_FFNPOST, I_PLEPRE, I_WPG, I_WPP, I_PLEPOST, N_INPUTS };
constexpr size_t MiB = 1u << 20;
constexpr size_t WS_CTL = 0;
constexpr size_t WS_RINVX = 1 * MiB;
constexpr size_t WS_SSQY = WS_RINVX + 128 * 1024;
constexpr size_t WS_CT = WS_SSQY + 128 * 1024;
constexpr size_t WS_KN = WS_CT + 8 * 1024;
constexpr size_t WS_KPMS = WS_CT + 16 * 1024;
constexpr size_t WS_LF = 2 * MiB;
constexpr size_t WS_CL = 3 * MiB;
constexpr size_t WS_C2 = 4 * MiB;
constexpr size_t WS_COS = 5 * MiB;
constexpr size_t WS_SIN = 9 * MiB;
constexpr size_t WS_SSQP = 13 * MiB;
constexpr size_t WS_W = 16 * MiB;
constexpr size_t W_IN = 0, W_O = W_IN + (size_t)ZP * 1024 * 2, W_G = W_O + 2 * MiB, W_U = W_G + 8 * MiB, W_D = W_U + 8 * MiB, W_PG = W_D + 8 * MiB, W_PP = W_PG + 2 * MiB;
constexpr size_t WS_PB = 52 * MiB;
constexpr size_t WS_XB = 68 * MiB;
constexpr size_t WS_RB = 132 * MiB;
constexpr size_t WS_RA = 232 * MiB;
constexpr size_t WS_END = 488 * MiB;
static_assert(W_PP + 512 * 1024 <= 36 * MiB, "weights");

struct Params { const float* in[N_INPUTS]; float* out; unsigned char* ws; float lg2gam[6]; int pad[2]; };

DI float wave_sum(float v) {
#pragma unroll
    for (int o = 1; o < 64; o <<= 1) v += __shfl_xor(v, o);
    return v;
}
DI int crow(int reg, int h) { return (reg & 3) + 8 * (reg >> 2) + 4 * h; }
DI unsigned short f2bf(float f) { return (unsigned short)(pk2(f, 0.f) & 0xffffu); }
DI float bf2f(unsigned short h) { return __uint_as_float((unsigned)h << 16); }
DI bf16x8 pack8(const f32x16& x, int s8) { u32x4 p; p.x = pk2(x[s8], x[s8 + 1]); p.y = pk2(x[s8 + 2], x[s8 + 3]); p.z = pk2(x[s8 + 4], x[s8 + 5]); p.w = pk2(x[s8 + 6], x[s8 + 7]); return __builtin_bit_cast(bf16x8, p); }

DI void transpose_item(const float* W, const float* g, int K, int N, int nblk, bf16* WT, float* scr, int item, int lane) {
    const int kb = item / nblk, nb = item % nblk, k0 = 64 * kb, n0 = 32 * nb;
    const int n = n0 + (lane & 31); const bool ok = n < N;
#pragma unroll 8
    for (int i = 0; i < 32; ++i) { const int kk = 2 * i + (lane >> 5); float v = ok ? W[(size_t)(k0 + kk) * N + n] : 0.f; if (g) v *= g[k0 + kk]; scr[kk * 33 + (lane & 31)] = v; }
    asm volatile("s_waitcnt lgkmcnt(0)" ::: "memory");
    const int c = lane & 7;
#pragma unroll
    for (int j = 0; j < 4; ++j) { const int nn = (lane >> 3) + 8 * j; const float* s = scr + (8 * c) * 33 + nn;
        u32x4 o; o.x = pk2(s[0 * 33], s[1 * 33]); o.y = pk2(s[2 * 33], s[3 * 33]); o.z = pk2(s[4 * 33], s[5 * 33]); o.w = pk2(s[6 * 33], s[7 * 33]);
        *(u32x4*)(WT + (size_t)(n0 + nn) * K + k0 + 8 * c) = o; }
    asm volatile("s_waitcnt lgkmcnt(0)" ::: "memory");
}
DI void convert_weights(const Params& P, int layer, char* lds, int gw, int NGW, int wave, int lane) {
    float* scr = (float*)(lds + wave * 16384);
    unsigned char* wb = P.ws + WS_W;
    constexpr int I_IN = 16 * 104, I_O = 16 * 32, I_G = 16 * 128, I_D = 64 * 32, I_PG = 16 * 32, I_PP = 4 * 32;
    constexpr int NITEMS = I_IN + I_O + 2 * I_G + I_D + I_PG + I_PP;
    for (int it = gw; it < NITEMS; it += NGW) {
        int r = it;
        if (r < I_IN) { transpose_item(P.in[I_WIN] + (size_t)layer * 1024 * NIN, P.in[I_MIXPRE] + layer * 1024, 1024, NIN, 104, (bf16*)(wb + W_IN), scr, r, lane); continue; } r -= I_IN;
        if (r < I_O) { transpose_item(P.in[I_WO] + (size_t)layer * 1024 * 1024, nullptr, 1024, 1024, 32, (bf16*)(wb + W_O), scr, r, lane); continue; } r -= I_O;
        if (r < I_G) { transpose_item(P.in[I_WGATE] + (size_t)layer * 1024 * DFF, P.in[I_FFNPRE] + layer * 1024, 1024, DFF, 128, (bf16*)(wb + W_G), scr, r, lane); continue; } r -= I_G;
        if (r < I_G) { transpose_item(P.in[I_WUP] + (size_t)layer * 1024 * DFF, P.in[I_FFNPRE] + layer * 1024, 1024, DFF, 128, (bf16*)(wb + W_U), scr, r, lane); continue; } r -= I_G;
        if (r < I_D) { transpose_item(P.in[I_WDOWN] + (size_t)layer * DFF * 1024, nullptr, DFF, 1024, 32, (bf16*)(wb + W_D), scr, r, lane); continue; } r -= I_D;
        if (r < I_PG) { transpose_item(P.in[I_WPG] + (size_t)layer * 1024 * 1024, P.in[I_PLEPRE] + layer * 1024, 1024, 1024, 32, (bf16*)(wb + W_PG), scr, r, lane); continue; } r -= I_PG;
        transpose_item(P.in[I_WPP] + (size_t)layer * 256 * 1024, nullptr, 256, 1024, 32, (bf16*)(wb + W_PP), scr, r, lane);
    }
    const float* pp = P.in[I_P] + (size_t)layer * T * 256; bf16* pb = (bf16*)(P.ws + WS_PB);
    for (size_t i = (size_t)gw * 64 + lane; i < (size_t)T * 256 / 8; i += (size_t)NGW * 64) {
        const f32x4 a = *(const f32x4*)(pp + i * 8), b = *(const f32x4*)(pp + i * 8 + 4);
        u32x4 o; o.x = pk2(a[0], a[1]); o.y = pk2(a[2], a[3]); o.z = pk2(b[0], b[1]); o.w = pk2(b[2], b[3]);
        *(u32x4*)(pb + i * 8) = o; }
}
DI void resid_rows(const Params& P, const float* xsrc, float* xdst, const bf16* Y, const float* gain, int gw, int NGW, int lane) {
    const float* ssqp = (const float*)(P.ws + WS_SSQP); float* rinvx = (float*)(P.ws + WS_RINVX); bf16* XB = (bf16*)(P.ws + WS_XB);
    for (int row = gw; row < T; row += NGW) {
        const size_t off = (size_t)row * 1024 + lane * 8;
        float v[16];
#pragma unroll
        for (int j = 0; j < 2; ++j) { const f32x4 a = *(const f32x4*)(xsrc + off + j * 512), b = *(const f32x4*)(xsrc + off + j * 512 + 4);
            v[8 * j + 0] = a[0]; v[8 * j + 1] = a[1]; v[8 * j + 2] = a[2]; v[8 * j + 3] = a[3]; v[8 * j + 4] = b[0]; v[8 * j + 5] = b[1]; v[8 * j + 6] = b[2]; v[8 * j + 7] = b[3]; }
        if (Y) { float sp = lane < 16 ? ssqp[(size_t)row * 16 + lane] : 0.f; sp = wave_sum(sp); const float ry = rsqrtf(sp * (1.0f / 1024.0f) + EPS);
#pragma unroll
            for (int j = 0; j < 2; ++j) { const u32x4 y = *(const u32x4*)(Y + off + j * 512); const f32x4 g0 = *(const f32x4*)(gain + lane * 8 + j * 512), g1 = *(const f32x4*)(gain + lane * 8 + j * 512 + 4);
                v[8 * j + 0] += bflo(y.x) * ry * g0[0]; v[8 * j + 1] += bfhi(y.x) * ry * g0[1]; v[8 * j + 2] += bflo(y.y) * ry * g0[2]; v[8 * j + 3] += bfhi(y.y) * ry * g0[3];
                v[8 * j + 4] += bflo(y.z) * ry * g1[0]; v[8 * j + 5] += bfhi(y.z) * ry * g1[1]; v[8 * j + 6] += bflo(y.w) * ry * g1[2]; v[8 * j + 7] += bfhi(y.w) * ry * g1[3]; }
        }
        float ss = 0.f;
#pragma unroll
        for (int k = 0; k < 16; ++k) ss += v[k] * v[k];
        ss = wave_sum(ss);
#pragma unroll
        for (int j = 0; j < 2; ++j) {
            if (xdst) { *(f32x4*)(xdst + off + j * 512) = (f32x4){v[8 * j], v[8 * j + 1], v[8 * j + 2], v[8 * j + 3]}; *(f32x4*)(xdst + off + j * 512 + 4) = (f32x4){v[8 * j + 4], v[8 * j + 5], v[8 * j + 6], v[8 * j + 7]}; }
            u32x4 o; o.x = pk2(v[8 * j], v[8 * j + 1]); o.y = pk2(v[8 * j + 2], v[8 * j + 3]); o.z = pk2(v[8 * j + 4], v[8 * j + 5]); o.w = pk2(v[8 * j + 6], v[8 * j + 7]);
            *(u32x4*)(XB + off + j * 512) = o; }
        if (lane == 0) rinvx[row] = rsqrtf(ss * (1.0f / 1024.0f) + EPS);
    }
}
DI void rope_table(const Params& P, int gtid, int NT) {
    const int* pos = (const int*)P.in[I_POS]; float* C = (float*)(P.ws + WS_COS); float* Sn = (float*)(P.ws + WS_SIN);
    for (int i = gtid; i < T * 32; i += NT) { const int row = i >> 5, j = i & 31;
        const double invf = exp2(-(double)j * (13.287712379549449 / 32.0));
        const double ang = (double)pos[row] * invf;
        const double q = rint(ang * 0.6366197723675814); const double y = fma(-q, 1.5707963267948966, ang) - q * 6.123233995736766e-17;
        const double y2 = y * y;
        const double sp = y * (1.0 + y2 * (-1.0 / 6 + y2 * (1.0 / 120 + y2 * (-1.0 / 5040 + y2 * (1.0 / 362880 + y2 * (-1.0 / 39916800))))));
        const double cp = 1.0 + y2 * (-0.5 + y2 * (1.0 / 24 + y2 * (-1.0 / 720 + y2 * (1.0 / 40320 + y2 * (-1.0 / 3628800 + y2 * (1.0 / 479001600))))));
        const int qi = (int)((long long)q & 3);
        const double sv = (qi == 0) ? sp : (qi == 1) ? cp : (qi == 2) ? -sp : -cp;
        const double cv = (qi == 0) ? cp : (qi == 1) ? -sp : (qi == 2) ? -cp : sp;
        C[i] = (float)cv; Sn[i] = (float)sv; }
}
constexpr int ST72 = 72, ST136 = 136, ST68 = 68;
DI void sgu_unit(const Params& P, int layer, int b, int c, int hh, char* lds) {
    int tid_u = threadIdx.x; asm volatile("" : "+v"(tid_u)); const int tid = tid_u, lane = tid & 63, wid = tid >> 6, r = lane & 31, h = lane >> 5;
    bf16* Wt = (bf16*)lds; bf16* VT = Wt + 128 * ST136;
    const bf16* Z = (const bf16*)(P.ws + WS_RA); bf16* MIX = (bf16*)(P.ws + WS_RB);
    const float* W = P.in[I_SGUW] + (size_t)(layer * 4 + hh) * 128 * 128;
#pragma unroll
    for (int j = 0; j < 8; ++j) { const int idx = (j * 512 + tid) * 4, t = idx >> 7, s = idx & 127; const f32x4 w = *(const f32x4*)(W + idx);
        u32x2 o; o.x = pk2(s <= t ? w[0] : 0.f, s + 1 <= t ? w[1] : 0.f); o.y = pk2(s + 2 <= t ? w[2] : 0.f, s + 3 <= t ? w[3] : 0.f);
        *(u32x2*)(Wt + t * ST136 + s) = o; }
    const size_t row0 = (size_t)b * S + (size_t)c * 128;
    { const int s = tid >> 2, dq = tid & 3; const bf16* vp = Z + (row0 + s) * ZP + 256 + hh * 64 + dq * 16;
      const u32x4 a = *(const u32x4*)vp, bb = *(const u32x4*)(vp + 8); float v[16];
      v[0] = bflo(a.x); v[1] = bfhi(a.x); v[2] = bflo(a.y); v[3] = bfhi(a.y); v[4] = bflo(a.z); v[5] = bfhi(a.z); v[6] = bflo(a.w); v[7] = bfhi(a.w);
      v[8] = bflo(bb.x); v[9] = bfhi(bb.x); v[10] = bflo(bb.y); v[11] = bfhi(bb.y); v[12] = bflo(bb.z); v[13] = bfhi(bb.z); v[14] = bflo(bb.w); v[15] = bfhi(bb.w);
      float ss = 0.f;
#pragma unroll
      for (int i = 0; i < 16; ++i) ss += v[i] * v[i];
      ss += __shfl_xor(ss, 1); ss += __shfl_xor(ss, 2);
      const float rn = rsqrtf(ss * (1.0f / 64.0f) + EPS); const float* g = P.in[I_SGUVG] + (layer * 4 + hh) * 64 + dq * 16;
#pragma unroll
      for (int i = 0; i < 16; ++i) VT[(dq * 16 + i) * ST136 + s] = f2bf(v[i] * rn * g[i]); }
    __syncthreads();
    const int tb = wid >> 1, db = wid & 1; f32x16 acc = {};
    for (int ks = 0; ks < 2 * (tb + 1); ++ks) { const bf16x8 a = *(const bf16x8*)(Wt + (32 * tb + r) * ST136 + 16 * ks + 8 * h); const bf16x8 bb = *(const bf16x8*)(VT + (32 * db + r) * ST136 + 16 * ks + 8 * h); acc = MFMA32(a, bb, acc); }
    const float* bs = P.in[I_SGUB] + (layer * 4 + hh) * 128;
#pragma unroll
    for (int i = 0; i < 16; ++i) { const int t = 32 * tb + crow(i, h), d = 32 * db + r; const float uu = bf2f(Z[(row0 + t) * ZP + hh * 64 + d]);
        MIX[(row0 + t) * 1024 + hh * 64 + d] = f2bf(uu * (acc[i] + bs[t])); }
    __syncthreads();
}
DI void load_rot(const bf16* zh, const float* cs, const float* sn, int dq, float scale, float (&o1)[8], float (&o2)[8]) {
    const u32x4 a = *(const u32x4*)(zh + dq * 8), bb = *(const u32x4*)(zh + 32 + dq * 8);
    const f32x4 c0 = *(const f32x4*)(cs + dq * 8), c1 = *(const f32x4*)(cs + dq * 8 + 4), s0 = *(const f32x4*)(sn + dq * 8), s1 = *(const f32x4*)(sn + dq * 8 + 4);
    float x1[8] = {bflo(a.x), bfhi(a.x), bflo(a.y), bfhi(a.y), bflo(a.z), bfhi(a.z), bflo(a.w), bfhi(a.w)};
    float x2[8] = {bflo(bb.x), bfhi(bb.x), bflo(bb.y), bfhi(bb.y), bflo(bb.z), bfhi(bb.z), bflo(bb.w), bfhi(bb.w)};
#pragma unroll
    for (int j = 0; j < 8; ++j) { const float cc = j < 4 ? c0[j & 3] : c1[j & 3], sv = j < 4 ? s0[j & 3] : s1[j & 3];
        o1[j] = (x1[j] * cc - x2[j] * sv) * scale; o2[j] = (x1[j] * sv + x2[j] * cc) * scale; }
}
DI void ret1_unit(const Params& P, float lg, int b, int hh, int c, char* lds) {
    int tid_u = threadIdx.x; asm volatile("" : "+v"(tid_u)); const int tid = tid_u, lane = tid & 63, wid = tid >> 6, r = lane & 31, h = lane >> 5;
    bf16* KT = (bf16*)lds; bf16* VT = KT + 64 * ST136;
    const bf16* Z = (const bf16*)(P.ws + WS_RA); float* ST = (float*)(P.ws + WS_RB + 64 * MiB);
    const size_t row0 = (size_t)b * S + (size_t)c * 128;
    { const int s = tid >> 2, dq = tid & 3; const size_t row = row0 + s; float o1[8], o2[8];
      load_rot(Z + row * ZP + 896 + hh * 64, (const float*)(P.ws + WS_COS) + row * 32, (const float*)(P.ws + WS_SIN) + row * 32, dq, 0.125f * __builtin_amdgcn_exp2f((float)(127 - s) * lg), o1, o2);
#pragma unroll
      for (int j = 0; j < 8; ++j) { KT[(dq * 8 + j) * ST136 + s] = f2bf(o1[j]); KT[(32 + dq * 8 + j) * ST136 + s] = f2bf(o2[j]); }
      const bf16* vp = Z + row * ZP + 1280 + hh * 64 + dq * 16; const u32x4 a = *(const u32x4*)vp, bb = *(const u32x4*)(vp + 8);
      const unsigned vv[8] = {a.x, a.y, a.z, a.w, bb.x, bb.y, bb.z, bb.w};
#pragma unroll
      for (int i = 0; i < 8; ++i) { VT[(dq * 16 + 2 * i) * ST136 + s] = (bf16)(vv[i] & 0xffffu); VT[(dq * 16 + 2 * i + 1) * ST136 + s] = (bf16)(vv[i] >> 16); } }
    __syncthreads();
    if (wid < 4) { const int db = wid >> 1, eb = wid & 1; f32x16 acc = {};
#pragma unroll
        for (int ks = 0; ks < 8; ++ks) { const bf16x8 a = *(const bf16x8*)(KT + (32 * db + r) * ST136 + 16 * ks + 8 * h); const bf16x8 bb = *(const bf16x8*)(VT + (32 * eb + r) * ST136 + 16 * ks + 8 * h); acc = MFMA32(a, bb, acc); }
        float* st = ST + ((size_t)((b * 6 + hh) * NCH + c)) * 4096;
#pragma unroll
        for (int i = 0; i < 16; ++i) st[(32 * db + crow(i, h)) * 64 + 32 * eb + r] = acc[i]; }
    __syncthreads();
}
DI void cum_unit(const Params& P, int b, int c) {
    int tid_u = threadIdx.x; asm volatile("" : "+v"(tid_u)); const int tid = tid_u, lane = tid & 63, wid = tid >> 6;
    if (wid < 6) { const float* LF = (const float*)(P.ws + WS_LF); float* CL = (float*)(P.ws + WS_CL); float* CT = (float*)(P.ws + WS_CT);
        const size_t row = (size_t)b * S + (size_t)c * 128 + 2 * lane; const float v0 = LF[row * 8 + wid], v1 = LF[(row + 1) * 8 + wid];
        float x = v0 + v1;
#pragma unroll
        for (int o = 1; o < 64; o <<= 1) { const float y = __shfl_up(x, o); if (lane >= o) x += y; }
        float* cl = CL + (size_t)(b * 6 + wid) * S + (size_t)c * 128 + 2 * lane; cl[0] = x - v1; cl[1] = x;
        if (lane == 63) CT[(b * 6 + wid) * NCH + c] = x;
        const bf16* Z = (const bf16*)(P.ws + WS_RA); float km = 0.f;
#pragma unroll
        for (int rr = 0; rr < 2; ++rr) { const bf16* kp = Z + (row + rr) * ZP + 2432 + wid * 64; float ss = 0.f;
#pragma unroll
            for (int j = 0; j < 8; ++j) { const u32x4 w = *(const u32x4*)(kp + 8 * j);
                ss += bflo(w.x) * bflo(w.x) + bfhi(w.x) * bfhi(w.x) + bflo(w.y) * bflo(w.y) + bfhi(w.y) * bfhi(w.y) + bflo(w.z) * bflo(w.z) + bfhi(w.z) * bfhi(w.z) + bflo(w.w) * bflo(w.w) + bfhi(w.w) * bfhi(w.w); }
            km = fmaxf(km, ss); }
#pragma unroll
        for (int o = 1; o < 64; o <<= 1) km = fmaxf(km, __shfl_xor(km, o));
        if (lane == 0) ((float*)(P.ws + WS_KN))[(b * 6 + wid) * NCH + c] = km; }
}
DI void ret3_unit(const Params& P, float lg, int b, int hh, int c, char* lds) {
    int tid_u = threadIdx.x; asm volatile("" : "+v"(tid_u)); const int tid = tid_u, lane = tid & 63, wid = tid >> 6, r = lane & 31, h = lane >> 5;
    bf16* Q = (bf16*)lds; bf16* K = Q + 128 * ST72; bf16* VT = K + 128 * ST72; bf16* RT = VT + 64 * ST136; bf16* Pm = RT + 64 * ST72; float* O = (float*)lds;
    const bf16* Z = (const bf16*)(P.ws + WS_RA); bf16* MIX = (bf16*)(P.ws + WS_RB); const float* ST = (const float*)(P.ws + WS_RB + 64 * MiB) + ((size_t)((b * 6 + hh) * NCH + c)) * 4096;
    const size_t row0 = (size_t)b * S + (size_t)c * 128;
    { const int s = tid >> 2, dq = tid & 3; const size_t row = row0 + s; float o1[8], o2[8];
      const float* cs = (const float*)(P.ws + WS_COS) + row * 32; const float* sn = (const float*)(P.ws + WS_SIN) + row * 32;
      load_rot(Z + row * ZP + 512 + hh * 64, cs, sn, dq, 1.0f, o1, o2);
      { u32x4 w; w.x = pk2(o1[0], o1[1]); w.y = pk2(o1[2], o1[3]); w.z = pk2(o1[4], o1[5]); w.w = pk2(o1[6], o1[7]); *(u32x4*)(Q + s * ST72 + dq * 8) = w;
        w.x = pk2(o2[0], o2[1]); w.y = pk2(o2[2], o2[3]); w.z = pk2(o2[4], o2[5]); w.w = pk2(o2[6], o2[7]); *(u32x4*)(Q + s * ST72 + 32 + dq * 8) = w; }
      load_rot(Z + row * ZP + 896 + hh * 64, cs, sn, dq, 0.125f, o1, o2);
      { u32x4 w; w.x = pk2(o1[0], o1[1]); w.y = pk2(o1[2], o1[3]); w.z = pk2(o1[4], o1[5]); w.w = pk2(o1[6], o1[7]); *(u32x4*)(K + s * ST72 + dq * 8) = w;
        w.x = pk2(o2[0], o2[1]); w.y = pk2(o2[2], o2[3]); w.z = pk2(o2[4], o2[5]); w.w = pk2(o2[6], o2[7]); *(u32x4*)(K + s * ST72 + 32 + dq * 8) = w; }
      const bf16* vp = Z + row * ZP + 1280 + hh * 64 + dq * 16; const u32x4 a = *(const u32x4*)vp, bb = *(const u32x4*)(vp + 8);
      const unsigned vv[8] = {a.x, a.y, a.z, a.w, bb.x, bb.y, bb.z, bb.w};
#pragma unroll
      for (int i = 0; i < 8; ++i) { VT[(dq * 16 + 2 * i) * ST136 + s] = (bf16)(vv[i] & 0xffffu); VT[(dq * 16 + 2 * i + 1) * ST136 + s] = (bf16)(vv[i] >> 16); }
      const int d = tid >> 3, e0 = (tid & 7) * 8; const f32x4 r0 = *(const f32x4*)(ST + d * 64 + e0), r1 = *(const f32x4*)(ST + d * 64 + e0 + 4);
#pragma unroll
      for (int i = 0; i < 4; ++i) { RT[(e0 + i) * ST72 + d] = f2bf(r0[i]); RT[(e0 + 4 + i) * ST72 + d] = f2bf(r1[i]); } }
    __syncthreads();
    for (int blk = wid; blk < 10; blk += 8) {
        const int tb = blk < 1 ? 0 : blk < 3 ? 1 : blk < 6 ? 2 : 3, sb = blk - (tb * (tb + 1)) / 2; f32x16 acc = {};
#pragma unroll
        for (int ks = 0; ks < 4; ++ks) { const bf16x8 a = *(const bf16x8*)(Q + (32 * tb + r) * ST72 + 16 * ks + 8 * h); const bf16x8 bb = *(const bf16x8*)(K + (32 * sb + r) * ST72 + 16 * ks + 8 * h); acc = MFMA32(a, bb, acc); }
#pragma unroll
        for (int i = 0; i < 16; ++i) { const int t = 32 * tb + crow(i, h), s = 32 * sb + r; const float v = s <= t ? acc[i] * __builtin_amdgcn_exp2f((float)(t - s) * lg) : 0.f; Pm[t * ST136 + s] = f2bf(v); }
    }
    __syncthreads();
    const int tb = wid >> 1, eb = wid & 1; f32x16 a1 = {}, a2 = {};
    for (int ks = 0; ks < 2 * (tb + 1); ++ks) { const bf16x8 a = *(const bf16x8*)(Pm + (32 * tb + r) * ST136 + 16 * ks + 8 * h); const bf16x8 bb = *(const bf16x8*)(VT + (32 * eb + r) * ST136 + 16 * ks + 8 * h); a1 = MFMA32(a, bb, a1); }
#pragma unroll
    for (int ks = 0; ks < 4; ++ks) { const bf16x8 a = *(const bf16x8*)(Q + (32 * tb + r) * ST72 + 16 * ks + 8 * h); const bf16x8 bb = *(const bf16x8*)(RT + (32 * eb + r) * ST72 + 16 * ks + 8 * h); a2 = MFMA32(a, bb, a2); }
    __syncthreads();
#pragma unroll
    for (int i = 0; i < 16; ++i) { const int t = 32 * tb + crow(i, h); O[t * 65 + 32 * eb + r] = a1[i] + a2[i] * __builtin_amdgcn_exp2f((float)(t + 1) * lg); }
    __syncthreads();
    { const int t = tid >> 2, eq = tid & 3; float v[16]; float ss = 0.f;
#pragma unroll
      for (int i = 0; i < 16; ++i) { v[i] = O[t * 65 + eq * 16 + i]; ss += v[i] * v[i]; }
      ss += __shfl_xor(ss, 1); ss += __shfl_xor(ss, 2);
      const float rn = rsqrtf(ss * (1.0f / 64.0f) + EPS); const size_t row = row0 + t;
      const bf16* gp = Z + row * ZP + 1664 + hh * 64 + eq * 16; const u32x4 ga = *(const u32x4*)gp, gb = *(const u32x4*)(gp + 8);
      const unsigned gg[8] = {ga.x, ga.y, ga.z, ga.w, gb.x, gb.y, gb.z, gb.w}; unsigned ow[8];
#pragma unroll
      for (int i = 0; i < 8; ++i) { const float g0 = bflo(gg[i]), g1 = bfhi(gg[i]);
          ow[i] = pk2(g0 * pg8::sigmoid_f(g0) * v[2 * i] * rn, g1 * pg8::sigmoid_f(g1) * v[2 * i + 1] * rn); }
      bf16* op = MIX + row * 1024 + 256 + hh * 64 + eq * 16;
      *(u32x4*)op = (u32x4){ow[0], ow[1], ow[2], ow[3]}; *(u32x4*)(op + 8) = (u32x4){ow[4], ow[5], ow[6], ow[7]}; }
    __syncthreads();
}
DI void fox_unit(const Params& P, int b, int hh, int qb, char* lds) {
    int tid_u = threadIdx.x; asm volatile("" : "+v"(tid_u)); const int tid = tid_u, lane = tid & 63, wid = tid >> 6, r = lane & 31, h = lane >> 5;
    bf16* Kt = (bf16*)lds; bf16* VT = Kt + 2 * 64 * ST72; float* NC = (float*)(VT + 2 * 64 * ST68);
    const bf16* Z = (const bf16*)(P.ws + WS_RA); bf16* MIX = (bf16*)(P.ws + WS_RB);
    const size_t rowb = (size_t)b * S; const int q0 = qb * 256;
    const float* c2 = (const float*)(P.ws + WS_C2) + (size_t)(b * 6 + hh) * S; const float cref = c2[q0];
    const int qrow = q0 + 32 * wid + r;
    bf16x8 qf[4];
    { const bf16* qp = Z + (rowb + qrow) * ZP + 2048 + hh * 64; const float sc = 0.125f * LOG2E;
#pragma unroll
      for (int s = 0; s < 4; ++s) { const u32x4 w = *(const u32x4*)(qp + 16 * s + 8 * h); u32x4 o;
          o.x = pk2(bflo(w.x) * sc, bfhi(w.x) * sc); o.y = pk2(bflo(w.y) * sc, bfhi(w.y) * sc); o.z = pk2(bflo(w.z) * sc, bfhi(w.z) * sc); o.w = pk2(bflo(w.w) * sc, bfhi(w.w) * sc);
          qf[s] = __builtin_bit_cast(bf16x8, o); } }
    float qn;
    { float ss = 0.f;
#pragma unroll
      for (int s = 0; s < 4; ++s) { const u32x4 w = __builtin_bit_cast(u32x4, qf[s]);
          ss += bflo(w.x) * bflo(w.x) + bfhi(w.x) * bfhi(w.x) + bflo(w.y) * bflo(w.y) + bfhi(w.y) * bfhi(w.y) + bflo(w.z) * bflo(w.z) + bfhi(w.z) * bfhi(w.z) + bflo(w.w) * bflo(w.w) + bfhi(w.w) * bfhi(w.w); }
      ss += __shfl_xor(ss, 32);
#pragma unroll
      for (int o = 1; o < 32; o <<= 1) ss = fmaxf(ss, __shfl_xor(ss, o));
      qn = sqrtf(ss) * 1.001f; }
    const float* kpms = (const float*)(P.ws + WS_KPMS) + (b * 6 + hh) * NCH;
    volatile unsigned* dflag = (volatile unsigned*)(NC + 128);
    if (tid < 8) dflag[tid] = 0u;
    bool done = false;
    f32x16 o0 = {}, o1 = {}; float m = -INFINITY, l = 0.f;
    const int ntile = 4 * (qb + 1);
    const int lrow = tid >> 3, lch = tid & 7;
    const bf16* kg = Z + (rowb + lrow) * ZP + 2432 + hh * 64 + lch * 8; const bf16* vg = Z + (rowb + lrow) * ZP + 2816 + hh * 64 + lch * 8;
    u32x4 kreg, vreg; float ncreg = 0.f;
#define FOX_LOAD(t) do { kreg = *(const u32x4*)(kg + (size_t)(t) * 64 * ZP); vreg = *(const u32x4*)(vg + (size_t)(t) * 64 * ZP); if (tid < 64) ncreg = cref - c2[64 * (t) + tid]; } while (0)
#define FOX_STORE(bufi) do { *(u32x4*)(Kt + (bufi) * 64 * ST72 + lrow * ST72 + lch * 8) = kreg; bf16* vt_ = VT + (bufi) * 64 * ST68 + (lch * 8) * ST68 + lrow; \
        vt_[0] = (bf16)(vreg.x & 0xffffu); vt_[ST68] = (bf16)(vreg.x >> 16); vt_[2 * ST68] = (bf16)(vreg.y & 0xffffu); vt_[3 * ST68] = (bf16)(vreg.y >> 16); \
        vt_[4 * ST68] = (bf16)(vreg.z & 0xffffu); vt_[5 * ST68] = (bf16)(vreg.z >> 16); vt_[6 * ST68] = (bf16)(vreg.w & 0xffffu); vt_[7 * ST68] = (bf16)(vreg.w >> 16); \
        if (tid < 64) NC[(bufi) * 64 + tid] = ncreg; } while (0)
    FOX_LOAD(ntile - 1); FOX_STORE(0); __syncthreads();
    int buf = 0;
    for (int t = ntile - 1; t >= 0; --t) {
        float c2n = 0.f, kpn = 0.f;
        if (t > 0) { FOX_LOAD(t - 1); c2n = c2[64 * t - 1]; kpn = kpms[(t - 1) >> 1]; }
        const int kv0 = 64 * t;
        if (!done && kv0 <= q0 + 32 * wid + 31) {
            const bf16* Kb = Kt + buf * 64 * ST72; const bf16* Vb = VT + buf * 64 * ST68; const float* NCb = NC + buf * 64;
            f32x16 p0 = {}, p1 = {};
#pragma unroll
            for (int s = 0; s < 4; ++s) { const bf16x8 a0 = *(const bf16x8*)(Kb + r * ST72 + 16 * s + 8 * h), a1 = *(const bf16x8*)(Kb + (32 + r) * ST72 + 16 * s + 8 * h);
                p0 = MFMA32(a0, qf[s], p0); p1 = MFMA32(a1, qf[s], p1); }
#pragma unroll
            for (int g = 0; g < 4; ++g) { const f32x4 n0 = *(const f32x4*)(NCb + 8 * g + 4 * h), n1 = *(const f32x4*)(NCb + 32 + 8 * g + 4 * h);
#pragma unroll
                for (int j = 0; j < 4; ++j) { p0[4 * g + j] += n0[j]; p1[4 * g + j] += n1[j]; } }
            if (kv0 + 63 > q0 + 32 * wid) {
#pragma unroll
                for (int i = 0; i < 16; ++i) { const int kv = kv0 + crow(i, h); if (kv > qrow) p0[i] = -INFINITY; if (kv + 32 > qrow) p1[i] = -INFINITY; } }
            float mx = fmaxf(p0[0], p1[0]);
#pragma unroll
            for (int i = 1; i < 16; ++i) mx = fmaxf(mx, fmaxf(p0[i], p1[i]));
            mx = fmaxf(mx, __shfl_xor(mx, 32));
            const float mn = fmaxf(m, mx), mu = (mn == -INFINITY) ? 0.f : mn; const float alpha = __builtin_amdgcn_exp2f(m - mu); m = mn;
            float ls = 0.f;
#pragma unroll
            for (int i = 0; i < 16; ++i) { p0[i] = __builtin_amdgcn_exp2f(p0[i] - mu); p1[i] = __builtin_amdgcn_exp2f(p1[i] - mu); ls += p0[i] + p1[i]; }
            l = l * alpha + ls;
#pragma unroll
            for (int i = 0; i < 16; ++i) { o0[i] *= alpha; o1[i] *= alpha; }
#pragma unroll
            for (int blk = 0; blk < 2; ++blk)
#pragma unroll
                for (int s = 0; s < 2; ++s) { const bf16x8 pf = blk == 0 ? pack8(p0, 8 * s) : pack8(p1, 8 * s); const int kvo = 32 * blk + 16 * s + 4 * h;
                    const u32x2 l0 = *(const u32x2*)(Vb + r * ST68 + kvo), h0 = *(const u32x2*)(Vb + r * ST68 + kvo + 8);
                    const u32x2 l1 = *(const u32x2*)(Vb + (32 + r) * ST68 + kvo), h1 = *(const u32x2*)(Vb + (32 + r) * ST68 + kvo + 8);
                    const u32x4 v0 = {l0.x, l0.y, h0.x, h0.y}, v1 = {l1.x, l1.y, h1.x, h1.y};
                    o0 = MFMA32(__builtin_bit_cast(bf16x8, v0), pf, o0); o1 = MFMA32(__builtin_bit_cast(bf16x8, v1), pf, o1); }
            if (t > 0) { float mm = m;
#pragma unroll
                for (int o = 1; o < 32; o <<= 1) mm = fminf(mm, __shfl_xor(mm, o));
                const float mmu = __uint_as_float(__builtin_amdgcn_readfirstlane(__float_as_uint(mm)));
                if (qn * kpn + (cref - c2n) < mmu - 40.0f) done = true; }
        }
        if (t > 0) FOX_STORE(buf ^ 1);
        if (done && lane == 0) dflag[wid] = 1u;
        __syncthreads();
        buf ^= 1;
        if ((dflag[0] & dflag[1] & dflag[2] & dflag[3] & dflag[4] & dflag[5] & dflag[6] & dflag[7]) != 0u) break;
    }
#undef FOX_LOAD
#undef FOX_STORE
    l += __shfl_xor(l, 32); const float inv = 1.0f / l;
    bf16* op = MIX + (rowb + qrow) * 1024 + 640 + hh * 64;
#pragma unroll
    for (int g = 0; g < 4; ++g) { u32x2 w; w.x = pk2(o0[4 * g] * inv, o0[4 * g + 1] * inv); w.y = pk2(o0[4 * g + 2] * inv, o0[4 * g + 3] * inv); *(u32x2*)(op + 8 * g + 4 * h) = w;
        w.x = pk2(o1[4 * g] * inv, o1[4 * g + 1] * inv); w.y = pk2(o1[4 * g + 2] * inv, o1[4 * g + 3] * inv); *(u32x2*)(op + 32 + 8 * g + 4 * h) = w; }
}
#ifndef PMASK
#define PMASK 0xffff
#endif
#define PEN(k) ((PMASK >> (k)) & 1)
#ifndef DUP
#define DUP 0
#endif
#ifndef XSYNC
#define XSYNC 0
#endif
#define REP(k) for (int rep_ = 0; rep_ < 1 + ((DUP >> (k)) & 1); ++rep_)
constexpr int LDS_BYTES = 147456;
constexpr int LDS_QW = 140 * 1024;
#define LAS __attribute__((address_space(3)))
#define XB_TMO      128
#define XB_XCNT(j)  (256  + 64 * (j))
#define XB_XSUB(j)  (1280 + 64 * (j))
#define XB_XGEN(j)  (2304 + 64 * (j))
#define XB_TOP      3328
#define XB_TOPGEN   3392
#define XCD_BAR_WORDS 3456
#define XB_SPIN_CAP (1u << 18)

__device__ __forceinline__ unsigned xb_ld(unsigned* p)              { return __hip_atomic_load(p, __ATOMIC_RELAXED, __HIP_MEMORY_SCOPE_AGENT); }
__device__ __forceinline__ unsigned xb_add(unsigned* p, unsigned v) { return __hip_atomic_fetch_add(p, v, __ATOMIC_RELAXED, __HIP_MEMORY_SCOPE_AGENT); }
__device__ __forceinline__ unsigned xb_xcc_id() { return (unsigned)__builtin_amdgcn_s_getreg((3 << 11) | 20) & 0xFu; }
#define XB_SPIN(cond, bar) do { unsigned _sp = 0; while (cond) { __builtin_amdgcn_s_sleep(1); \
    if ((++_sp & 255u) == 0u) { if (xb_ld(&(bar)[XB_TMO])) break; if (_sp > XB_SPIN_CAP) { atomicAdd(&(bar)[XB_TMO], 1u); break; } } } } while (0)

struct XcdBarrier {
    unsigned* bar; unsigned x;
    volatile LAS unsigned* st;
};

__device__ __forceinline__ XcdBarrier xcd_barrier_post(unsigned* bar, volatile LAS unsigned* st) {
    XcdBarrier b; b.bar = bar; b.x = xb_xcc_id(); b.st = st;
    if (threadIdx.x == 0) (void)xb_add(&bar[XB_XCNT(b.x)], 1u);
    return b;
}
__device__ __forceinline__ void xcd_barrier_complete(unsigned* bar, unsigned x, unsigned& nloc, unsigned& nx) {
    const unsigned G = gridDim.x * gridDim.y * gridDim.z;
    unsigned sum, cnt, mine, sp = 0u;
    for (;;) {
        sum = 0u; cnt = 0u; mine = 0u;
#pragma unroll
        for (unsigned j = 0; j < 16; ++j) { const unsigned c = xb_ld(&bar[XB_XCNT(j)]); sum += c; cnt += (c > 0u) ? 1u : 0u; mine = (j == x) ? c : mine; }
        if (sum == G) break;
        __builtin_amdgcn_s_sleep(1);
        if ((++sp & 255u) == 0u) { if (xb_ld(&bar[XB_TMO])) break; if (sp > XB_SPIN_CAP) { atomicAdd(&bar[XB_TMO], 1u); break; } }
    }
    nloc = mine > 0u ? mine : 1u; nx = cnt > 0u ? cnt : 1u;
}

__device__ __forceinline__ void xcd_barrier(const XcdBarrier& b) {
    asm volatile("s_waitcnt vmcnt(0)" ::: "memory");
    __syncthreads();
    if (threadIdx.x == 0) {
        unsigned* bar = b.bar;
        __builtin_amdgcn_s_waitcnt(0);
        unsigned nloc = b.st[0], nx = b.st[1];
        if (nloc == 0u) { xcd_barrier_complete(bar, b.x, nloc, nx); b.st[0] = nloc; b.st[1] = nx; }
        const unsigned old = xb_add(&bar[XB_XSUB(b.x)], 1u);
        const unsigned gen = old / nloc;
        if (old + 1u == (gen + 1u) * nloc) {
            __builtin_amdgcn_fence(__ATOMIC_RELEASE, "agent");
            asm volatile("s_waitcnt vmcnt(0)" ::: "memory");
            const unsigned og = xb_add(&bar[XB_TOP], 1u);
            const unsigned tg = og / nx;
            if (og + 1u == (tg + 1u) * nx) xb_add(&bar[XB_TOPGEN], 1u);
            else XB_SPIN(xb_ld(&bar[XB_TOPGEN]) == tg, bar);
            __builtin_amdgcn_fence(__ATOMIC_ACQUIRE, "agent");
            xb_add(&bar[XB_XGEN(b.x)], 1u);
            asm volatile("s_waitcnt vmcnt(0)" ::: "memory");
        } else {
            XB_SPIN(xb_ld(&bar[XB_XGEN(b.x)]) == gen, bar);
            __builtin_amdgcn_fence(__ATOMIC_ACQUIRE, "agent");
            asm volatile("s_waitcnt vmcnt(0)" ::: "memory");
        }
    }
    __syncthreads();
}

constexpr int CW_BAR = 4096;
constexpr int LDS_MISC = 141 * 1024;
typedef const __attribute__((address_space(4))) Params* kparams_t;
#if defined(__HIP_DEVICE_COMPILE__)
#define PH_COPY const Params P = *pp_;
#else
#define PH_COPY const Params P = Pk; const Params* pp_h = &Pk; (void)pp_h;
#endif
#define PH_BEGIN  kparams_t pp_ = (kparams_t)__builtin_amdgcn_kernarg_segment_ptr(); asm volatile("" : "+s"(pp_)); PH_COPY \
    int tid_ = threadIdx.x; asm volatile("" : "+v"(tid_)); const int tid = tid_, lane = tid & 63, wave = __builtin_amdgcn_readfirstlane(tid >> 6); \
    const int G = gridDim.x, bx = blockIdx.x, gw = bx * 8 + wave, NGW = G * 8; unsigned char* ws = P.ws; (void)lane; (void)gw; (void)NGW; (void)ws; \
    PG8_LAS unsigned char* L = (PG8_LAS unsigned char*)lds; (void)L;
#define GRID_SYNC() do { kparams_t pg_ = (kparams_t)__builtin_amdgcn_kernarg_segment_ptr(); XcdBarrier xb_; xb_.bar = (unsigned*)(pg_->ws + WS_CTL) + CW_BAR; xb_.x = xb_xcc_id(); \
    xb_.st = (volatile LAS unsigned*)((LAS unsigned char*)lds + LDS_MISC); xcd_barrier(xb_); } while (0)
#define WSP(T_, off) ((T_*)(ws + (off)))
__global__ void __launch_bounds__(512, 2) fwd_kernel(Params Pk) {
    extern __shared__ __attribute__((aligned(16))) unsigned char lds[];
    cg::grid_group grid = cg::this_grid();
    { volatile LAS unsigned* st = (volatile LAS unsigned*)((LAS unsigned char*)lds + LDS_MISC);
      if (threadIdx.x < 2) st[threadIdx.x] = 0u;
      __syncthreads();
      kparams_t pq_ = (kparams_t)__builtin_amdgcn_kernarg_segment_ptr();
      (void)xcd_barrier_post((unsigned*)(pq_->ws + WS_CTL) + CW_BAR, st); }
    { PH_BEGIN
      convert_weights(P, 0, (char*)lds, gw, NGW, wave, lane);
      rope_table(P, bx * 512 + tid, G * 512);
      resid_rows(P, P.in[I_X], nullptr, nullptr, nullptr, gw, NGW, lane); }
    asm volatile("s_waitcnt vmcnt(0) lgkmcnt(0)" ::: "memory"); grid.sync(); __builtin_amdgcn_fence(__ATOMIC_ACQUIRE, "agent"); asm volatile("s_waitcnt vmcnt(0)" ::: "memory");
    for (int layer = 0; layer < DEPTH; ++layer) {
        if (PEN(1)) REP(1) { PH_BEGIN
          pg8::Gemm g{WSP(bf16, WS_XB), WSP(const bf16, WS_W + W_IN), T, ZP, 1024}; pg8::StaticOrder So; So.init(T, ZP, G, bx);
          pg8::EpiZ E{WSP(bf16, WS_RA), WSP(float, WS_RINVX), WSP(float, WS_LF), P.in[I_FOXB] + layer * 6};
          pg8::gemm_phase<pg8::EpiZ, pg8::StaticOrder, true, true>(L, g, So, E); }
        GRID_SYNC();
        if (PEN(2)) REP(2) { PH_BEGIN
          for (int u = bx; u < 1024 + 1536 + 256; u += G) {
            if (u < 1024) { sgu_unit(P, layer, u >> 9, (u >> 2) & 127, u & 3, (char*)lds); }
            else if (u < 2560) { const int v = u - 1024, bh = v / NCH, c = v % NCH; ret1_unit(P, pp_->lg2gam[bh % 6], bh / 6, bh % 6, c, (char*)lds); }
            else { const int v = u - 2560; cum_unit(P, v >> 7, v & 127); } } }
        GRID_SYNC();
        if (PEN(3)) { PH_BEGIN
          float* ST = (float*)(ws + WS_RB + 64 * MiB);
          for (int e = bx * 512 + tid; e < 12 * 4096; e += G * 512) { const int bh = e >> 12, de = e & 4095; const float g128 = __builtin_amdgcn_exp2f(128.0f * pp_->lg2gam[bh % 6]);
              float* p = ST + (size_t)bh * NCH * 4096 + de; float carry = 0.f;
#pragma unroll 8
              for (int c = 0; c < NCH; ++c) { const float s = p[(size_t)c * 4096]; p[(size_t)c * 4096] = carry; carry = carry * g128 + s; } }
          const float* CT = (const float*)(ws + WS_CT); const float* CL = (const float*)(ws + WS_CL); float* C2 = (float*)(ws + WS_C2);
          for (int u = bx; u < 12 * NCH; u += G) { const int bh = u / NCH, c = u % NCH;
              if (tid < 128) { const float* KN = (const float*)(ws + WS_KN); float pre = 0.f, kpm = KN[bh * NCH + c]; for (int cc = 0; cc < c; ++cc) { pre += CT[bh * NCH + cc]; kpm = fmaxf(kpm, KN[bh * NCH + cc]); }
                  const size_t i = (size_t)bh * S + (size_t)c * 128 + tid; C2[i] = (pre + CL[i]) * LOG2E;
                  if (tid == 0) ((float*)(ws + WS_KPMS))[bh * NCH + c] = sqrtf(kpm); } } }
        GRID_SYNC();
        if (PEN(4)) REP(4) { PH_BEGIN
          unsigned* qctr = WSP(unsigned, WS_CTL) + 64 * (1 + layer) + 256 * rep_; volatile unsigned* qw = (volatile unsigned*)(lds + LDS_QW);
          for (;;) { if (tid == 0) *qw = atomicAdd(qctr, 1u);
              __syncthreads(); const unsigned u = *qw; __syncthreads();
              if (u >= 768u + 1536u) break;
              if (u < 768u) { const int qb = 63 - (int)(u / 12u), bh = (int)(u % 12u); fox_unit(P, bh / 6, bh % 6, qb, (char*)lds); }
              else { const int v = (int)u - 768, bh = v / NCH, c = v % NCH; ret3_unit(P, pp_->lg2gam[bh % 6], bh / 6, bh % 6, c, (char*)lds); } } }
        GRID_SYNC();
        if (PEN(5)) REP(5) { PH_BEGIN
          pg8::Gemm g{WSP(bf16, WS_RB), WSP(const bf16, WS_W + W_O), T, 1024, 1024}; pg8::StaticOrder So; So.init(T, 1024, G, bx);
          pg8::EpiY E{WSP(bf16, WS_RA), WSP(float, WS_SSQP), 1024}; pg8::gemm_phase<pg8::EpiY, pg8::StaticOrder, true, true>(L, g, So, E); }
        GRID_SYNC();
        { PH_BEGIN
          resid_rows(P, layer == 0 ? P.in[I_X] : P.out, P.out, WSP(bf16, WS_RA), P.in[I_MIXPOST] + layer * 1024, gw, NGW, lane); }
        GRID_SYNC();
        if (PEN(7)) for (int st = 0; st < 5; ++st) { REP(7) {
            if (st == 2 || st == 4) { PH_BEGIN
                const int hb = (st - 2) >> 1;
                pg8::Gemm g{WSP(bf16, WS_RA) + (size_t)S * DFF, WSP(const bf16, WS_W + W_D), S, 1024, DFF}; pg8::StaticOrder So; So.init(S, 1024, G, bx);
                pg8::EpiY E{WSP(bf16, WS_RB) + (size_t)hb * S * 1024, WSP(float, WS_SSQP) + (size_t)hb * S * 16, 1024}; pg8::gemm_phase<pg8::EpiY, pg8::StaticOrder, true, true>(L, g, So, E); }
            if (st == 0 || st == 2) { PH_BEGIN
                const int hb = st >> 1;
                pg8::Gemm g{WSP(bf16, WS_XB) + (size_t)hb * S * 1024, WSP(const bf16, WS_W + W_G), S, DFF, 1024}; pg8::StaticOrder So; So.init(S, DFF, G, bx);
                pg8::EpiS E{WSP(bf16, WS_RA), WSP(float, WS_RINVX) + hb * S, DFF}; pg8::gemm_phase<pg8::EpiS, pg8::StaticOrder, true, true>(L, g, So, E); }
            if (st == 1 || st == 3) { PH_BEGIN
                const int hb = st >> 1;
                pg8::Gemm g{WSP(bf16, WS_XB) + (size_t)hb * S * 1024, WSP(const bf16, WS_W + W_U), S, DFF, 1024}; pg8::StaticOrder So; So.init(S, DFF, G, bx);
                pg8::EpiAct E{WSP(bf16, WS_RA) + (size_t)S * DFF, WSP(const bf16, WS_RA), WSP(float, WS_RINVX) + hb * S, P.in[I_CONVW] + (size_t)layer * 3 * DFF, P.in[I_CONVB] + (size_t)layer * DFF};
                pg8::gemm_phase<pg8::EpiAct, pg8::StaticOrder, true, true>(L, g, So, E); }
            }
            GRID_SYNC();
        }
        if (PEN(10)) REP(10) { PH_BEGIN
          int kd_ = 256; asm volatile("" : "+s"(kd_));
          pg8::Gemm g{WSP(const bf16, WS_PB), WSP(const bf16, WS_W + W_PP), T, 1024, kd_}; pg8::StaticOrder So; So.init(T, 1024, G, bx);
          pg8::EpiS E{WSP(bf16, WS_RA), nullptr, 1024}; pg8::gemm_phase<pg8::EpiS, pg8::StaticOrder, true, true>(L, g, So, E); }
        { PH_BEGIN
          resid_rows(P, P.out, P.out, WSP(bf16, WS_RB), P.in[I_FFNPOST] + layer * 1024, gw, NGW, lane); }
        GRID_SYNC();
        if (PEN(11)) REP(11) { PH_BEGIN
          pg8::Gemm g{WSP(bf16, WS_XB), WSP(const bf16, WS_W + W_PG), T, 1024, 1024}; pg8::StaticOrder So; So.init(T, 1024, G, bx);
          pg8::EpiPle E{WSP(bf16, WS_RB), WSP(const bf16, WS_RA), WSP(float, WS_RINVX), WSP(float, WS_SSQP)}; pg8::gemm_phase<pg8::EpiPle, pg8::StaticOrder, true, true>(L, g, So, E); }
        GRID_SYNC();
        { PH_BEGIN
          resid_rows(P, P.out, P.out, WSP(bf16, WS_RB), P.in[I_PLEPOST] + layer * 1024, gw, NGW, lane);
          if (layer + 1 < DEPTH) { __syncthreads(); convert_weights(P, layer + 1, (char*)lds, gw, NGW, wave, lane); } }
        if (layer + 1 < DEPTH) GRID_SYNC();
        for (int xs_ = 0; xs_ < XSYNC; ++xs_) GRID_SYNC();
    }
}

extern "C" void kernel_launch(void* const* d_in, const int* in_sizes, int n_in, void* d_out, int out_size, void* d_ws, size_t ws_size, hipStream_t stream) {
    static int grid = 0;
    if (grid == 0) {
        if (n_in != N_INPUTS || ws_size < WS_END) { fprintf(stderr, "kernel_launch: unexpected n_in %d / ws_size %zu\n", n_in, ws_size); grid = -1; return; }
        int dev = 0, cus = 0, per_cu = 0;
        (void)hipGetDevice(&dev); (void)hipDeviceGetAttribute(&cus, hipDeviceAttributeMultiprocessorCount, dev);
        (void)hipFuncSetAttribute((const void*)fwd_kernel, hipFuncAttributeMaxDynamicSharedMemorySize, LDS_BYTES);
        (void)hipOccupancyMaxActiveBlocksPerMultiprocessor(&per_cu, (const void*)fwd_kernel, 512, LDS_BYTES);
        if (per_cu < 1) { fprintf(stderr, "kernel_launch: occupancy query says %d blocks/CU\n", per_cu); per_cu = 1; }
        grid = cus;
    }
    if (grid < 0) return;
    (void)hipMemsetAsync((char*)d_ws + WS_CTL, 0, 65536, stream);
    Params p; memset(&p, 0, sizeof(p));
    for (int i = 0; i < N_INPUTS; ++i) p.in[i] = (const float*)d_in[i];
    p.out = (float*)d_out; p.ws = (unsigned char*)d_ws;
    for (int h = 0; h < 6; ++h) p.lg2gam[h] = (float)log2(1.0 - exp2(-5.0 - (double)h));
    void* args[] = {&p};
    hipError_t e = hipLaunchCooperativeKernel((const void*)fwd_kernel, dim3(grid), dim3(512), args, LDS_BYTES, stream);
    if (e != hipSuccess) fprintf(stderr, "cooperative launch failed: %s (grid %d)\n", hipGetErrorString(e), grid);
}
```

```cpp
#include <hip/hip_runtime.h>
#include <hip/hip_cooperative_groups.h>
#include <cstdio>
#include <cstdint>
#include <cmath>
#include <cstring>
namespace cg = cooperative_groups;
namespace pg8 {
#define PG8_LAS __attribute__((address_space(3)))
typedef unsigned short bf16_t;
typedef short bf16x8 __attribute__((ext_vector_type(8)));
typedef float f32x4 __attribute__((ext_vector_type(4)));
typedef unsigned u32x4 __attribute__((ext_vector_type(4)));
constexpr int BM = 256, BK = 64, HALF = 128, HTB = HALF * BK * 2  , STAGE_BYTES = 8 * HTB, NXCD = 8, WGM = 8;

__host__ __device__ __forceinline__ int lds_byte(int r, int c) { const int st = (r >> 4) * 2 + (c >> 5), rr = r & 15, cc = c & 31, ob = rr * 64 + cc * 2; return st * 1024 + (ob ^ (((ob >> 9) & 1) << 5)); }
__host__ __device__ __forceinline__ void stage_rc(int b, int& R, int& C) { const int st = b / 1024, sb = b % 1024, swz = sb ^ (((sb >> 9) & 1) << 5); R = (st >> 1) * 16 + swz / 64; C = (st & 1) * 32 + (swz % 64) / 2; }
__host__ __device__ __forceinline__ int perm32(int rho) { const int n = rho >> 4, i = rho & 15; return 8 * (i >> 2) + 4 * n + (i & 3); }

struct Unit { int pm, pn; };
struct Gemm { const bf16_t* A; const bf16_t* Bt; int M, N, K; };

struct StaticOrder {
    int nM, nN, nwg, G, c;
    __host__ __device__ void init(int M, int N, int G_, int c_) { nM = M / BM; nN = N / BM; nwg = nM * nN; G = G_; c = c_; }
    __host__ __device__ bool next(int i, Unit& u) const {
        const long L = (long)i * G + c; if (L >= nwg) return false;
        int wgid = (int)L; { const int q = nwg / NXCD, r = nwg % NXCD, xcd = wgid % NXCD, off = wgid / NXCD; wgid = (xcd < r ? xcd * (q + 1) : r * (q + 1) + (xcd - r) * q) + off; }
        const int nig = WGM * nN, gid = wgid / nig, fm = gid * WGM, gsz = (nM - fm) < WGM ? (nM - fm) : WGM;
        u.pm = fm + ((wgid % nig) % gsz); u.pn = (wgid % nig) / gsz; return true;
    }
    __device__ __forceinline__ void a_ready(const Unit&) const {}
    __device__ __forceinline__ void done(const Unit&) const {}
};

__device__ __forceinline__ unsigned cvt_pk_bf16(float lo, float hi) { unsigned r; asm volatile("v_cvt_pk_bf16_f32 %0, %1, %2" : "=v"(r) : "v"(lo), "v"(hi)); return r; }
typedef float f32x2 __attribute__((ext_vector_type(2)));
__device__ __forceinline__ f32x2 gelu_pk(f32x2 v) {
    const f32x2 av = __builtin_elementwise_abs(v), d = av * 0.2316418882f + 1.0f;
    f32x2 t; t.x = __builtin_amdgcn_rcpf(d.x); t.y = __builtin_amdgcn_rcpf(d.y);
    f32x2 q = t * 0.5307027145f + (-0.7265760135f); q = q * t + 0.7107068705f; q = q * t + (-0.142248368f); q = q * t + 0.127414796f; q = q * t;
    const f32x2 s = (v * v) * (-0.72134752044f);
    f32x2 e; e.x = __builtin_amdgcn_exp2f(s.x); e.y = __builtin_amdgcn_exp2f(s.y);
    const f32x2 m = v * (q * e), r = v - m;
    f32x2 o; o.x = v.x < 0.f ? m.x : r.x; o.y = v.y < 0.f ? m.y : r.y; return o;
}

template <int ACT  > struct EpiBf16 {
    static constexpr bool PERM = true, AFTER_DRAIN = false; static_assert(ACT == 0 || ACT == 1, "EpiBf16: ACT is 0 (none) or 1 (gelu_pk)");
    bf16_t* O; int ldc; const float* bias; int split_cols; size_t split_stride; float scale0;
    __device__ __forceinline__ void operator()(const f32x4 (&acc)[2][2][4][2], const Unit& u, int wr, int wc, int fr, int fq) const {
        const int row0 = u.pm * BM + wr * 64 + fr; int colt = u.pn * BM; bf16_t* base = O;
        float sc = 1.f; if (split_cols) { const int t = colt / split_cols; base += (size_t)t * split_stride; colt -= t * split_cols; if (t == 0) sc = scale0; }
        const int col0 = colt + wc * 32 + 8 * fq, bcol0 = u.pn * BM + wc * 32 + 8 * fq;
        f32x4 bv[2][2];
#pragma unroll
        for (int bj = 0; bj < 2; ++bj)
#pragma unroll
            for (int n = 0; n < 2; ++n) bv[bj][n] = bias ? *(const f32x4*)(bias + bcol0 + bj * HALF + 4 * n) : (f32x4){0.f, 0.f, 0.f, 0.f};
#pragma unroll
        for (int ai = 0; ai < 2; ++ai)
#pragma unroll
            for (int m = 0; m < 4; ++m) { bf16_t* rowp = base + (size_t)(row0 + ai * HALF + m * 16) * ldc + col0;
#pragma unroll
                for (int bj = 0; bj < 2; ++bj) { f32x4 v0 = acc[ai][bj][m][0] + bv[bj][0], v1 = acc[ai][bj][m][1] + bv[bj][1];
                    if (ACT == 1) { f32x2 a = gelu_pk((f32x2){v0[0], v0[1]}), b = gelu_pk((f32x2){v0[2], v0[3]}), c = gelu_pk((f32x2){v1[0], v1[1]}), d = gelu_pk((f32x2){v1[2], v1[3]});
                        v0 = (f32x4){a.x, a.y, b.x, b.y}; v1 = (f32x4){c.x, c.y, d.x, d.y}; }
                    v0 = v0 * sc; v1 = v1 * sc; u32x4 w; w.x = cvt_pk_bf16(v0[0], v0[1]); w.y = cvt_pk_bf16(v0[2], v0[3]); w.z = cvt_pk_bf16(v1[0], v1[1]); w.w = cvt_pk_bf16(v1[2], v1[3]);
                    *(u32x4*)(rowp + bj * HALF) = w; } }
    }
};

typedef float f32x2_t __attribute__((ext_vector_type(2))); typedef __bf16 bf16x2_t __attribute__((ext_vector_type(2)));
__device__ __forceinline__ unsigned pk2(float lo, float hi) { f32x2_t v = {lo, hi}; bf16x2_t b = __builtin_convertvector(v, bf16x2_t); return __builtin_bit_cast(unsigned, b); }
__device__ __forceinline__ float bflo(unsigned w) { return __uint_as_float(w << 16); }
__device__ __forceinline__ float bfhi(unsigned w) { return __uint_as_float(w & 0xffff0000u); }
__device__ __forceinline__ float gelu_tanh(float x) { const float t = x * (1.0f + 0.044715f * x * x); return x * __builtin_amdgcn_rcpf(1.0f + __builtin_amdgcn_exp2f(-2.3022082f * t)); }
__device__ __forceinline__ float sigmoid_f(float x) { return __builtin_amdgcn_rcpf(1.0f + __builtin_amdgcn_exp2f(-1.4426950409f * x)); }
__device__ __forceinline__ float logsigmoid_f(float x) { return fminf(x, 0.f) - log1pf(__expf(-fabsf(x))); }
constexpr int ZP = 3328;
struct EpiZ {
    static constexpr bool PERM = true, AFTER_DRAIN = false;
    bf16_t* Z; const float* rinv; float* LF; const float* bfv;
    __device__ __forceinline__ void operator()(const f32x4 (&acc)[2][2][4][2], const Unit& u, int wr, int wc, int fr, int fq) const {
        const int row0 = u.pm * BM + wr * 64 + fr, colb = u.pn * BM + wc * 32 + 8 * fq; const bool dog = u.pn < 2; const bool dof = (u.pn == 12) && (wc == 0) && (fq == 0);
#pragma unroll
        for (int ai = 0; ai < 2; ++ai)
#pragma unroll
            for (int m = 0; m < 4; ++m) { const int row = row0 + ai * HALF + m * 16; const float sc = rinv[row]; bf16_t* rowp = Z + (size_t)row * ZP + colb;
#pragma unroll
                for (int bj = 0; bj < 2; ++bj) { f32x4 v0 = acc[ai][bj][m][0] * sc, v1 = acc[ai][bj][m][1] * sc;
                    if (dog) { v0[0] = gelu_tanh(v0[0]); v0[1] = gelu_tanh(v0[1]); v0[2] = gelu_tanh(v0[2]); v0[3] = gelu_tanh(v0[3]); v1[0] = gelu_tanh(v1[0]); v1[1] = gelu_tanh(v1[1]); v1[2] = gelu_tanh(v1[2]); v1[3] = gelu_tanh(v1[3]); }
                    u32x4 w; w.x = pk2(v0[0], v0[1]); w.y = pk2(v0[2], v0[3]); w.z = pk2(v1[0], v1[1]); w.w = pk2(v1[2], v1[3]);
                    *(u32x4*)(rowp + bj * HALF) = w;
                    if (bj == 1 && dof) { float* lf = LF + (size_t)row * 8;
                        lf[0] = logsigmoid_f(v0[0] + bfv[0]); lf[1] = logsigmoid_f(v0[1] + bfv[1]); lf[2] = logsigmoid_f(v0[2] + bfv[2]); lf[3] = logsigmoid_f(v0[3] + bfv[3]);
                        lf[4] = logsigmoid_f(v1[0] + bfv[4]); lf[5] = logsigmoid_f(v1[1] + bfv[5]); } } }
    }
};
struct EpiY {
    static constexpr bool PERM = true, AFTER_DRAIN = false;
    bf16_t* Y; float* ssq; int ldc;
    __device__ __forceinline__ void operator()(const f32x4 (&acc)[2][2][4][2], const Unit& u, int wr, int wc, int fr, int fq) const {
        const int row0 = u.pm * BM + wr * 64 + fr, colb = u.pn * BM + wc * 32 + 8 * fq;
#pragma unroll
        for (int ai = 0; ai < 2; ++ai)
#pragma unroll
            for (int m = 0; m < 4; ++m) { const int row = row0 + ai * HALF + m * 16; bf16_t* rowp = Y + (size_t)row * ldc + colb; float ss = 0.f;
#pragma unroll
                for (int bj = 0; bj < 2; ++bj) { const f32x4 v0 = acc[ai][bj][m][0], v1 = acc[ai][bj][m][1];
                    ss += (v0[0] * v0[0] + v0[1] * v0[1]) + (v0[2] * v0[2] + v0[3] * v0[3]) + (v1[0] * v1[0] + v1[1] * v1[1]) + (v1[2] * v1[2] + v1[3] * v1[3]);
                    u32x4 w; w.x = pk2(v0[0], v0[1]); w.y = pk2(v0[2], v0[3]); w.z = pk2(v1[0], v1[1]); w.w = pk2(v1[2], v1[3]);
                    *(u32x4*)(rowp + bj * HALF) = w; }
                ss += __shfl_xor(ss, 16); ss += __shfl_xor(ss, 32);
                if (fq == 0) ssq[(size_t)row * 16 + (u.pn & 3) * 4 + wc] = ss; }
    }
};
struct EpiS {
    static constexpr bool PERM = true, AFTER_DRAIN = false;
    bf16_t* O; const float* rinv; int ldc;
    __device__ __forceinline__ void operator()(const f32x4 (&acc)[2][2][4][2], const Unit& u, int wr, int wc, int fr, int fq) const {
        const int row0 = u.pm * BM + wr * 64 + fr, colb = u.pn * BM + wc * 32 + 8 * fq;
#pragma unroll
        for (int ai = 0; ai < 2; ++ai)
#pragma unroll
            for (int m = 0; m < 4; ++m) { const int row = row0 + ai * HALF + m * 16; const float sc = rinv ? rinv[row] : 1.0f; bf16_t* rowp = O + (size_t)row * ldc + colb;
#pragma unroll
                for (int bj = 0; bj < 2; ++bj) { const f32x4 v0 = acc[ai][bj][m][0] * sc, v1 = acc[ai][bj][m][1] * sc;
                    u32x4 w; w.x = pk2(v0[0], v0[1]); w.y = pk2(v0[2], v0[3]); w.z = pk2(v1[0], v1[1]); w.w = pk2(v1[2], v1[3]);
                    *(u32x4*)(rowp + bj * HALF) = w; } }
    }
};
struct EpiAct {
    static constexpr bool PERM = true, AFTER_DRAIN = false;
    bf16_t* ACT; const bf16_t* G; const float* rinv; const float* cw; const float* cb;
    __device__ __forceinline__ void operator()(const f32x4 (&acc)[2][2][4][2], const Unit& u, int wr, int wc, int fr, int fq) const {
        const int row0 = u.pm * BM + wr * 64 + fr, colb = u.pn * BM + wc * 32 + 8 * fq;
#pragma unroll
        for (int bj = 0; bj < 2; ++bj) { const int col = colb + bj * HALF;
            float w0[8], w1[8], w2[8], b0[8];
#pragma unroll
            for (int j = 0; j < 2; ++j) { const f32x4 a = *(const f32x4*)(cw + col + 4 * j), b = *(const f32x4*)(cw + 4096 + col + 4 * j), c = *(const f32x4*)(cw + 8192 + col + 4 * j), d = *(const f32x4*)(cb + col + 4 * j);
#pragma unroll
                for (int k = 0; k < 4; ++k) { w0[4 * j + k] = a[k]; w1[4 * j + k] = b[k]; w2[4 * j + k] = c[k]; b0[4 * j + k] = d[k]; } }
#pragma unroll
            for (int ai = 0; ai < 2; ++ai)
#pragma unroll
                for (int m = 0; m < 4; ++m) { const int row = row0 + ai * HALF + m * 16; const float sc = rinv[row];
                    const bf16_t* gp = G + (size_t)row * 4096 + col; const u32x4 z4 = {0u, 0u, 0u, 0u};
                    const u32x4 g2 = *(const u32x4*)gp; const u32x4 g1 = row >= 1 ? *(const u32x4*)(gp - 4096) : z4; const u32x4 g0 = row >= 2 ? *(const u32x4*)(gp - 8192) : z4;
                    float o[8];
#pragma unroll
                    for (int k = 0; k < 4; ++k) { const unsigned a = g0[k], b = g1[k], c = g2[k];
                        const float c0 = b0[2 * k] + w0[2 * k] * bflo(a) + w1[2 * k] * bflo(b) + w2[2 * k] * bflo(c);
                        const float c1 = b0[2 * k + 1] + w0[2 * k + 1] * bfhi(a) + w1[2 * k + 1] * bfhi(b) + w2[2 * k + 1] * bfhi(c);
                        const float u0 = (k < 2 ? acc[ai][bj][m][0][2 * k] : acc[ai][bj][m][1][2 * k - 4]) * sc, u1 = (k < 2 ? acc[ai][bj][m][0][2 * k + 1] : acc[ai][bj][m][1][2 * k - 3]) * sc;
                        o[2 * k] = gelu_tanh(c0) * u0; o[2 * k + 1] = gelu_tanh(c1) * u1; }
                    u32x4 w; w.x = pk2(o[0], o[1]); w.y = pk2(o[2], o[3]); w.z = pk2(o[4], o[5]); w.w = pk2(o[6], o[7]);
                    *(u32x4*)(ACT + (size_t)row * 4096 + col) = w; } }
    }
};
struct EpiPle {
    static constexpr bool PERM = true, AFTER_DRAIN = false;
    bf16_t* Y; const bf16_t* E; const float* rinv; float* ssq;
    __device__ __forceinline__ void operator()(const f32x4 (&acc)[2][2][4][2], const Unit& u, int wr, int wc, int fr, int fq) const {
        const int row0 = u.pm * BM + wr * 64 + fr, colb = u.pn * BM + wc * 32 + 8 * fq;
#pragma unroll
        for (int ai = 0; ai < 2; ++ai)
#pragma unroll
            for (int m = 0; m < 4; ++m) { const int row = row0 + ai * HALF + m * 16; const float sc = rinv[row]; float ss = 0.f;
#pragma unroll
                for (int bj = 0; bj < 2; ++bj) { const size_t off = (size_t)row * 1024 + colb + bj * HALF; const u32x4 e = *(const u32x4*)(E + off);
                    const f32x4 v0 = acc[ai][bj][m][0] * sc, v1 = acc[ai][bj][m][1] * sc; float o[8];
                    o[0] = bflo(e.x) * sigmoid_f(v0[0]); o[1] = bfhi(e.x) * sigmoid_f(v0[1]); o[2] = bflo(e.y) * sigmoid_f(v0[2]); o[3] = bfhi(e.y) * sigmoid_f(v0[3]);
                    o[4] = bflo(e.z) * sigmoid_f(v1[0]); o[5] = bfhi(e.z) * sigmoid_f(v1[1]); o[6] = bflo(e.w) * sigmoid_f(v1[2]); o[7] = bfhi(e.w) * sigmoid_f(v1[3]);
#pragma unroll
                    for (int k = 0; k < 8; ++k) ss += o[k] * o[k];
                    u32x4 w; w.x = pk2(o[0], o[1]); w.y = pk2(o[2], o[3]); w.z = pk2(o[4], o[5]); w.w = pk2(o[6], o[7]);
                    *(u32x4*)(Y + off) = w; }
                ss += __shfl_xor(ss, 16); ss += __shfl_xor(ss, 32);
                if (fq == 0) ssq[(size_t)row * 16 + (u.pn & 3) * 4 + wc] = ss; }
    }
};
template <class Epi, class Sched, bool ALIGN_EPI = false, bool SP2 = false>
__device__ __forceinline__ void gemm_phase(PG8_LAS unsigned char* lds, const Gemm g, const Sched& S, const Epi& E) {
    int tid_o = threadIdx.x; asm volatile("" : "+v"(tid_o));
    const int tid = tid_o, wid = __builtin_amdgcn_readfirstlane(tid >> 6), lane = tid & 63, wr = wid >> 2, wc = wid & 3, fr = lane & 15, fq = lane >> 4;
    const int K = g.K, nt = K / BK;
    unsigned voffA[2], voffB[2];
#pragma unroll
    for (int i = 0; i < 2; ++i) { int R, C; stage_rc(tid * 16 + i * 8192, R, C); const int Rb = Epi::PERM ? ((R & ~31) + perm32(R & 31)) : R;
        voffA[i] = (unsigned)(R * K + C) * 2u; voffB[i] = (unsigned)(Rb * K + C) * 2u; }
    const size_t kstep = (size_t)(BK * 2);
    const size_t hstep = (size_t)HALF * K * 2;
    const size_t tstep = 2 * hstep;
    const unsigned ldsw = (unsigned)wid * 1024u;
    const int aoff = lds_byte(wr * 64 + fr, fq * 8), boff = lds_byte(wc * 32 + fr, fq * 8);
#define PG8_SA(b, h) (((b) * 2 + (h)) * HTB)
#define PG8_SB(b, h) ((4 + (b) * 2 + (h)) * HTB)
#define PG8_STAGE(bufoff, gbase, voff) do { _Pragma("unroll") for (int _i = 0; _i < 2; ++_i) \
        __builtin_amdgcn_global_load_lds((const unsigned*)((const char*)(gbase) + (voff)[_i]), (PG8_LAS unsigned*)(lds + (bufoff) + ldsw + _i * 8192), 16, 0, 0); } while (0)
#define PG8_LDA(dst, b, h) do { _Pragma("unroll") for (int m = 0; m < 4; ++m) _Pragma("unroll") for (int k = 0; k < 2; ++k) dst[m][k] = *(const PG8_LAS bf16x8*)(lds + PG8_SA(b, h) + aoff + m * 2048 + k * 1024); } while (0)
#define PG8_LDB(dst, b, h) do { _Pragma("unroll") for (int n = 0; n < 2; ++n) _Pragma("unroll") for (int k = 0; k < 2; ++k) dst[n][k] = *(const PG8_LAS bf16x8*)(lds + PG8_SB(b, h) + boff + n * 2048 + k * 1024); } while (0)
#define PG8_MMA(ai, bj, At, Bt) do { __builtin_amdgcn_s_setprio(1); _Pragma("unroll") for (int m = 0; m < 4; ++m) _Pragma("unroll") for (int n = 0; n < 2; ++n) _Pragma("unroll") for (int k = 0; k < 2; ++k) \
        acc[ai][bj][m][n] = __builtin_amdgcn_mfma_f32_16x16x32_bf16(Bt[n][k], At[m][k], acc[ai][bj][m][n], 0, 0, 0); __builtin_amdgcn_s_setprio(0); } while (0)
#define PG8_WAIT_V(n) asm volatile("s_waitcnt vmcnt(" #n ")" ::: "memory")
#define PG8_WAIT_L(n) asm volatile("s_waitcnt lgkmcnt(" #n ")" ::: "memory")
#define PG8_BAR __builtin_amdgcn_s_barrier()
#define PG8_SCHED __builtin_amdgcn_sched_barrier(0)
    Unit cur, nxt; int ui = 0;
    if (!S.next(0, cur)) return;
    f32x4 acc[2][2][4][2];
#pragma unroll
    for (int a = 0; a < 2; ++a)
#pragma unroll
        for (int b = 0; b < 2; ++b)
#pragma unroll
            for (int m = 0; m < 4; ++m)
#pragma unroll
                for (int n = 0; n < 2; ++n) acc[a][b][m][n] = (f32x4){0.f, 0.f, 0.f, 0.f};
    bf16x8 At[4][2], B0[2][2], B1[2][2];
    const char* cA = (const char*)g.A + (size_t)cur.pm * tstep; const char* cB = (const char*)g.Bt + (size_t)cur.pn * tstep;
    S.a_ready(cur);
    if constexpr (SP2) {
        PG8_STAGE(PG8_SB(0, 0), cB, voffB); PG8_STAGE(PG8_SB(0, 1), cB + hstep, voffB); PG8_STAGE(PG8_SA(0, 0), cA, voffA); PG8_STAGE(PG8_SA(0, 1), cA + hstep, voffA);
        if (wr == 1) PG8_BAR;
        PG8_WAIT_V(2); PG8_BAR;
        PG8_STAGE(PG8_SB(1, 0), cB + kstep, voffB); PG8_STAGE(PG8_SA(1, 0), cA + kstep, voffA); PG8_STAGE(PG8_SB(1, 1), cB + hstep + kstep, voffB);
        PG8_WAIT_V(6); PG8_BAR;
    } else {
        PG8_STAGE(PG8_SB(0, 0), cB, voffB); PG8_STAGE(PG8_SA(0, 0), cA, voffA); PG8_STAGE(PG8_SB(0, 1), cB + hstep, voffB); PG8_STAGE(PG8_SA(0, 1), cA + hstep, voffA);
        if (wr == 1) PG8_BAR;
        PG8_WAIT_V(4); PG8_BAR;
        PG8_STAGE(PG8_SB(1, 0), cB + kstep, voffB); PG8_STAGE(PG8_SA(1, 0), cA + kstep, voffA); PG8_STAGE(PG8_SB(1, 1), cB + hstep + kstep, voffB);
        PG8_WAIT_V(6); PG8_BAR;
    }
    for (;;) {
        const bool has_next = S.next(ui + 1, nxt);
        const char* nA = has_next ? (const char*)g.A + (size_t)nxt.pm * tstep : cA; const char* nB = has_next ? (const char*)g.Bt + (size_t)nxt.pn * tstep : cB;
        for (int t = 0; t < nt; t += 2) {
            const bool last = (t == nt - 2);
            const char* a1 = cA + (size_t)(t + 1) * kstep;
            const char* a2 = last ? nA : cA + (size_t)(t + 2) * kstep; const char* b2 = last ? nB : cB + (size_t)(t + 2) * kstep;
            const char* a3 = a2 + kstep; const char* b3 = b2 + kstep;
            if (last && has_next) S.a_ready(nxt);
            if constexpr (SP2) {
            PG8_LDB(B0, 0, 0); PG8_LDB(B1, 0, 1); PG8_SCHED; PG8_LDA(At, 0, 0); PG8_STAGE(PG8_SA(1, 1), a1 + hstep, voffA);
            PG8_WAIT_V(8); PG8_WAIT_L(0); PG8_BAR; PG8_MMA(0, 0, At, B0); PG8_MMA(0, 1, At, B1); PG8_BAR; PG8_SCHED;
            PG8_LDA(At, 0, 1); PG8_STAGE(PG8_SB(0, 0), b2, voffB); PG8_STAGE(PG8_SB(0, 1), b2 + hstep, voffB); PG8_STAGE(PG8_SA(0, 0), a2, voffA);
            PG8_WAIT_V(8); PG8_WAIT_L(0); PG8_BAR; PG8_MMA(1, 0, At, B0); PG8_MMA(1, 1, At, B1); PG8_BAR; PG8_SCHED;
            PG8_LDB(B0, 1, 0); PG8_LDB(B1, 1, 1); PG8_SCHED; PG8_LDA(At, 1, 0); PG8_STAGE(PG8_SA(0, 1), a2 + hstep, voffA);
            PG8_WAIT_V(8); PG8_WAIT_L(0); PG8_BAR; PG8_MMA(0, 0, At, B0); PG8_MMA(0, 1, At, B1); PG8_BAR; PG8_SCHED;
            PG8_LDA(At, 1, 1); PG8_STAGE(PG8_SB(1, 0), b3, voffB); PG8_STAGE(PG8_SB(1, 1), b3 + hstep, voffB); PG8_STAGE(PG8_SA(1, 0), a3, voffA);
            PG8_WAIT_V(8); PG8_WAIT_L(0); PG8_BAR; PG8_MMA(1, 0, At, B0); PG8_MMA(1, 1, At, B1); PG8_BAR; PG8_SCHED;
            } else {
            PG8_LDB(B0, 0, 0); PG8_SCHED; PG8_LDA(At, 0, 0); PG8_STAGE(PG8_SA(1, 1), a1 + hstep, voffA);
            PG8_WAIT_L(8); PG8_BAR; PG8_WAIT_L(0); PG8_MMA(0, 0, At, B0); PG8_BAR; PG8_SCHED;
            PG8_LDB(B1, 0, 1); PG8_STAGE(PG8_SB(0, 0), b2, voffB);
            PG8_BAR; PG8_WAIT_L(0); PG8_MMA(0, 1, At, B1); PG8_BAR;
            PG8_LDA(At, 0, 1); PG8_STAGE(PG8_SA(0, 0), a2, voffA);
            PG8_BAR; PG8_WAIT_L(0); PG8_MMA(1, 0, At, B0); PG8_BAR; PG8_SCHED;
            PG8_STAGE(PG8_SB(0, 1), b2 + hstep, voffB);
            PG8_WAIT_V(6); PG8_BAR; PG8_MMA(1, 1, At, B1); PG8_BAR;
            PG8_LDB(B0, 1, 0); PG8_SCHED; PG8_LDA(At, 1, 0); PG8_STAGE(PG8_SA(0, 1), a2 + hstep, voffA);
            PG8_WAIT_L(8); PG8_BAR; PG8_WAIT_L(0); PG8_MMA(0, 0, At, B0); PG8_BAR; PG8_SCHED;
            PG8_LDB(B1, 1, 1); PG8_STAGE(PG8_SB(1, 0), b3, voffB);
            PG8_BAR; PG8_WAIT_L(0); PG8_MMA(0, 1, At, B1); PG8_BAR;
            PG8_LDA(At, 1, 1); PG8_STAGE(PG8_SA(1, 0), a3, voffA);
            PG8_BAR; PG8_WAIT_L(0); PG8_MMA(1, 0, At, B0); PG8_BAR; PG8_SCHED;
            PG8_STAGE(PG8_SB(1, 1), b3 + hstep, voffB);
            PG8_WAIT_V(6); PG8_BAR; PG8_MMA(1, 1, At, B1); PG8_BAR;
            }
        }
        if constexpr (ALIGN_EPI) { if (wr == 0) PG8_BAR; }
        if constexpr (!Epi::AFTER_DRAIN) { E(acc, cur, wr, wc, fr, fq); S.done(cur); }
        if (!has_next) break;
#pragma unroll
        for (int a = 0; a < 2; ++a)
#pragma unroll
            for (int b = 0; b < 2; ++b)
#pragma unroll
                for (int m = 0; m < 4; ++m)
#pragma unroll
                    for (int n = 0; n < 2; ++n) acc[a][b][m][n] = (f32x4){0.f, 0.f, 0.f, 0.f};
        cur = nxt; cA = nA; cB = nB; ++ui;
        if constexpr (ALIGN_EPI) { if (wr == 1) PG8_BAR; }
    }
    PG8_WAIT_V(0);
    if constexpr (!ALIGN_EPI) { if (wr == 0) PG8_BAR; }
    PG8_BAR;
    if constexpr (Epi::AFTER_DRAIN) { E.fused(acc, cur, wr, wc, fr, fq, lds, wid, lane); S.done(cur); }
#undef PG8_SA
#undef PG8_SB
#undef PG8_STAGE
#undef PG8_LDA
#undef PG8_LDB
#undef PG8_MMA
#undef PG8_WAIT_V
#undef PG8_WAIT_L
#undef PG8_BAR
#undef PG8_SCHED
}
}
#define DI __device__ __forceinline__
typedef unsigned short bf16;
typedef short bf16x8 __attribute__((ext_vector_type(8)));
typedef float f32x4 __attribute__((ext_vector_type(4)));
typedef float f32x16 __attribute__((ext_vector_type(16)));
typedef unsigned u32x4 __attribute__((ext_vector_type(4)));
typedef unsigned u32x2 __attribute__((ext_vector_type(2)));
using pg8::pk2; using pg8::bflo; using pg8::bfhi; using pg8::ZP;
#define MFMA32(a, b, c) __builtin_amdgcn_mfma_f32_32x32x16_bf16((a), (b), (c), 0, 0, 0)
constexpr int NB = 2, S = 16384, T = NB * S, DM = 1024, DEPTH = 2, DFF = 4096, NIN = 3206;
constexpr float EPS = 1e-6f, LOG2E = 1.4426950408889634f;
constexpr int NCH = S / 128;
enum { I_X = 0, I_P, I_POS, I_MIXPRE, I_WIN, I_SGUVG, I_SGUW, I_SGUB, I_FOXB, I_WO, I_MIXPOST, I_FFNPRE, I_WGATE, I_WUP, I_CONVW, I_CONVB, I_WDOWN, I_FFNPOST, I_PLEPRE, I_WPG, I_WPP, I_PLEPOST, N_INPUTS };
constexpr size_t MiB = 1u << 20;
constexpr size_t WS_CTL = 0;
constexpr size_t WS_RINVX = 1 * MiB;
constexpr size_t WS_SSQY = WS_RINVX + 128 * 1024;
constexpr size_t WS_CT = WS_SSQY + 128 * 1024;
constexpr size_t WS_KN = WS_CT + 8 * 1024;
constexpr size_t WS_KPMS = WS_CT + 16 * 1024;
constexpr size_t WS_LF = 2 * MiB;
constexpr size_t WS_CL = 3 * MiB;
constexpr size_t WS_C2 = 4 * MiB;
constexpr size_t WS_COS = 5 * MiB;
constexpr size_t WS_SIN = 9 * MiB;
constexpr size_t WS_SSQP = 13 * MiB;
constexpr size_t WS_W = 16 * MiB;
constexpr size_t W_IN = 0, W_O = W_IN + (size_t)ZP * 1024 * 2, W_G = W_O + 2 * MiB, W_U = W_G + 8 * MiB, W_D = W_U + 8 * MiB, W_PG = W_D + 8 * MiB, W_PP = W_PG + 2 * MiB;
constexpr size_t WS_PB = 52 * MiB;
constexpr size_t WS_XB = 68 * MiB;
constexpr size_t WS_RB = 132 * MiB;
constexpr size_t WS_RA = 232 * MiB;
constexpr size_t WS_END = 488 * MiB;
static_assert(W_PP + 512 * 1024 <= 36 * MiB, "weights");

struct Params { const float* in[N_INPUTS]; float* out; unsigned char* ws; float lg2gam[6]; int pad[2]; };

DI float wave_sum(float v) {
#pragma unroll
    for (int o = 1; o < 64; o <<= 1) v += __shfl_xor(v, o);
    return v;
}
DI int crow(int reg, int h) { return (reg & 3) + 8 * (reg >> 2) + 4 * h; }
DI unsigned short f2bf(float f) { return (unsigned short)(pk2(f, 0.f) & 0xffffu); }
DI float bf2f(unsigned short h) { return __uint_as_float((unsigned)h << 16); }
DI bf16x8 pack8(const f32x16& x, int s8) { u32x4 p; p.x = pk2(x[s8], x[s8 + 1]); p.y = pk2(x[s8 + 2], x[s8 + 3]); p.z = pk2(x[s8 + 4], x[s8 + 5]); p.w = pk2(x[s8 + 6], x[s8 + 7]); return __builtin_bit_cast(bf16x8, p); }

DI void transpose_item(const float* W, const float* g, int K, int N, int nblk, bf16* WT, float* scr, int item, int lane) {
    const int kb = item / nblk, nb = item % nblk, k0 = 64 * kb, n0 = 32 * nb;
    const int n = n0 + (lane & 31); const bool ok = n < N;
#pragma unroll 8
    for (int i = 0; i < 32; ++i) { const int kk = 2 * i + (lane >> 5); float v = ok ? W[(size_t)(k0 + kk) * N + n] : 0.f; if (g) v *= g[k0 + kk]; scr[kk * 33 + (lane & 31)] = v; }
    asm volatile("s_waitcnt lgkmcnt(0)" ::: "memory");
    const int c = lane & 7;
#pragma unroll
    for (int j = 0; j < 4; ++j) { const int nn = (lane >> 3) + 8 * j; const float* s = scr + (8 * c) * 33 + nn;
        u32x4 o; o.x = pk2(s[0 * 33], s[1 * 33]); o.y = pk2(s[2 * 33], s[3 * 33]); o.z = pk2(s[4 * 33], s[5 * 33]); o.w = pk2(s[6 * 33], s[7 * 33]);
        *(u32x4*)(WT + (size_t)(n0 + nn) * K + k0 + 8 * c) = o; }
    asm volatile("s_waitcnt lgkmcnt(0)" ::: "memory");
}
DI void convert_weights(const Params& P, int layer, char* lds, int gw, int NGW, int wave, int lane) {
    float* scr = (float*)(lds + wave * 16384);
    unsigned char* wb = P.ws + WS_W;
    constexpr int I_IN = 16 * 104, I_O = 16 * 32, I_G = 16 * 128, I_D = 64 * 32, I_PG = 16 * 32, I_PP = 4 * 32;
    constexpr int NITEMS = I_IN + I_O + 2 * I_G + I_D + I_PG + I_PP;
    for (int it = gw; it < NITEMS; it += NGW) {
        int r = it;
        if (r < I_IN) { transpose_item(P.in[I_WIN] + (size_t)layer * 1024 * NIN, P.in[I_MIXPRE] + layer * 1024, 1024, NIN, 104, (bf16*)(wb + W_IN), scr, r, lane); continue; } r -= I_IN;
        if (r < I_O) { transpose_item(P.in[I_WO] + (size_t)layer * 1024 * 1024, nullptr, 1024, 1024, 32, (bf16*)(wb + W_O), scr, r, lane); continue; } r -= I_O;
        if (r < I_G) { transpose_item(P.in[I_WGATE] + (size_t)layer * 1024 * DFF, P.in[I_FFNPRE] + layer * 1024, 1024, DFF, 128, (bf16*)(wb + W_G), scr, r, lane); continue; } r -= I_G;
        if (r < I_G) { transpose_item(P.in[I_WUP] + (size_t)layer * 1024 * DFF, P.in[I_FFNPRE] + layer * 1024, 1024, DFF, 128, (bf16*)(wb + W_U), scr, r, lane); continue; } r -= I_G;
        if (r < I_D) { transpose_item(P.in[I_WDOWN] + (size_t)layer * DFF * 1024, nullptr, DFF, 1024, 32, (bf16*)(wb + W_D), scr, r, lane); continue; } r -= I_D;
        if (r < I_PG) { transpose_item(P.in[I_WPG] + (size_t)layer * 1024 * 1024, P.in[I_PLEPRE] + layer * 1024, 1024, 1024, 32, (bf16*)(wb + W_PG), scr, r, lane); continue; } r -= I_PG;
        transpose_item(P.in[I_WPP] + (size_t)layer * 256 * 1024, nullptr, 256, 1024, 32, (bf16*)(wb + W_PP), scr, r, lane);
    }
    const float* pp = P.in[I_P] + (size_t)layer * T * 256; bf16* pb = (bf16*)(P.ws + WS_PB);
    for (size_t i = (size_t)gw * 64 + lane; i < (size_t)T * 256 / 8; i += (size_t)NGW * 64) {
        const f32x4 a = *(const f32x4*)(pp + i * 8), b = *(const f32x4*)(pp + i * 8 + 4);
        u32x4 o; o.x = pk2(a[0], a[1]); o.y = pk2(a[2], a[3]); o.z = pk2(b[0], b[1]); o.w = pk2(b[2], b[3]);
        *(u32x4*)(pb + i * 8) = o; }
}
DI void resid_rows(const Params& P, const float* xsrc, float* xdst, const bf16* Y, const float* gain, int gw, int NGW, int lane) {
    const float* ssqp = (const float*)(P.ws + WS_SSQP); float* rinvx = (float*)(P.ws + WS_RINVX); bf16* XB = (bf16*)(P.ws + WS_XB);
    for (int row = gw; row < T; row += NGW) {
        const size_t off = (size_t)row * 1024 + lane * 8;
        float v[16];
#pragma unroll
        for (int j = 0; j < 2; ++j) { const f32x4 a = *(const f32x4*)(xsrc + off + j * 512), b = *(const f32x4*)(xsrc + off + j * 512 + 4);
            v[8 * j + 0] = a[0]; v[8 * j + 1] = a[1]; v[8 * j + 2] = a[2]; v[8 * j + 3] = a[3]; v[8 * j + 4] = b[0]; v[8 * j + 5] = b[1]; v[8 * j + 6] = b[2]; v[8 * j + 7] = b[3]; }
        if (Y) { float sp = lane < 16 ? ssqp[(size_t)row * 16 + lane] : 0.f; sp = wave_sum(sp); const float ry = rsqrtf(sp * (1.0f / 1024.0f) + EPS);
#pragma unroll
            for (int j = 0; j < 2; ++j) { const u32x4 y = *(const u32x4*)(Y + off + j * 512); const f32x4 g0 = *(const f32x4*)(gain + lane * 8 + j * 512), g1 = *(const f32x4*)(gain + lane * 8 + j * 512 + 4);
                v[8 * j + 0] += bflo(y.x) * ry * g0[0]; v[8 * j + 1] += bfhi(y.x) * ry * g0[1]; v[8 * j + 2] += bflo(y.y) * ry * g0[2]; v[8 * j + 3] += bfhi(y.y) * ry * g0[3];
                v[8 * j + 4] += bflo(y.z) * ry * g1[0]; v[8 * j + 5] += bfhi(y.z) * ry * g1[1]; v[8 * j + 6] += bflo(y.w) * ry * g1[2]; v[8 * j + 7] += bfhi(y.w) * ry * g1[3]; }
        }
        float ss = 0.f;
#pragma unroll
        for (int k = 0; k < 16; ++k) ss += v[k] * v[k];
        ss = wave_sum(ss);
#pragma unroll
        for (int j = 0; j < 2; ++j) {
            if (xdst) { *(f32x4*)(xdst + off + j * 512) = (f32x4){v[8 * j], v[8 * j + 1], v[8 * j + 2], v[8 * j + 3]}; *(f32x4*)(xdst + off + j * 512 + 4) = (f32x4){v[8 * j + 4], v[8 * j + 5], v[8 * j + 6], v[8 * j + 7]}; }
            u32x4 o; o.x = pk2(v[8 * j], v[8 * j + 1]); o.y = pk2(v[8 * j + 2], v[8 * j + 3]); o.z = pk2(v[8 * j + 4], v[8 * j + 5]); o.w = pk2(v[8 * j + 6], v[8 * j + 7]);
            *(u32x4*)(XB + off + j * 512) = o; }
        if (lane == 0) rinvx[row] = rsqrtf(ss * (1.0f / 1024.0f) + EPS);
    }
}
DI void rope_table(const Params& P, int gtid, int NT) {
    const int* pos = (const int*)P.in[I_POS]; float* C = (float*)(P.ws + WS_COS); float* Sn = (float*)(P.ws + WS_SIN);
    for (int i = gtid; i < T * 32; i += NT) { const int row = i >> 5, j = i & 31;
        const double invf = exp2(-(double)j * (13.287712379549449 / 32.0));
        const double ang = (double)pos[row] * invf;
        const double q = rint(ang * 0.6366197723675814); const double y = fma(-q, 1.5707963267948966, ang) - q * 6.123233995736766e-17;
        const double y2 = y * y;
        const double sp = y * (1.0 + y2 * (-1.0 / 6 + y2 * (1.0 / 120 + y2 * (-1.0 / 5040 + y2 * (1.0 / 362880 + y2 * (-1.0 / 39916800))))));
        const double cp = 1.0 + y2 * (-0.5 + y2 * (1.0 / 24 + y2 * (-1.0 / 720 + y2 * (1.0 / 40320 + y2 * (-1.0 / 3628800 + y2 * (1.0 / 479001600))))));
        const int qi = (int)((long long)q & 3);
        const double sv = (qi == 0) ? sp : (qi == 1) ? cp : (qi == 2) ? -sp : -cp;
        const double cv = (qi == 0) ? cp : (qi == 1) ? -sp : (qi == 2) ? -cp : sp;
        C[i] = (float)cv; Sn[i] = (float)sv; }
}
constexpr int ST72 = 72, ST136 = 136, ST68 = 68;
DI void sgu_unit(const Params& P, int layer, int b, int c, int hh, char* lds) {
    int tid_u = threadIdx.x; asm volatile("" : "+v"(tid_u)); const int tid = tid_u, lane = tid & 63, wid = tid >> 6, r = lane & 31, h = lane >> 5;
    bf16* Wt = (bf16*)lds; bf16* VT = Wt + 128 * ST136;
    const bf16* Z = (const bf16*)(P.ws + WS_RA); bf16* MIX = (bf16*)(P.ws + WS_RB);
    const float* W = P.in[I_SGUW] + (size_t)(layer * 4 + hh) * 128 * 128;
#pragma unroll
    for (int j = 0; j < 8; ++j) { const int idx = (j * 512 + tid) * 4, t = idx >> 7, s = idx & 127; const f32x4 w = *(const f32x4*)(W + idx);
        u32x2 o; o.x = pk2(s <= t ? w[0] : 0.f, s + 1 <= t ? w[1] : 0.f); o.y = pk2(s + 2 <= t ? w[2] : 0.f, s + 3 <= t ? w[3] : 0.f);
        *(u32x2*)(Wt + t * ST136 + s) = o; }
    const size_t row0 = (size_t)b * S + (size_t)c * 128;
    { const int s = tid >> 2, dq = tid & 3; const bf16* vp = Z + (row0 + s) * ZP + 256 + hh * 64 + dq * 16;
      const u32x4 a = *(const u32x4*)vp, bb = *(const u32x4*)(vp + 8); float v[16];
      v[0] = bflo(a.x); v[1] = bfhi(a.x); v[2] = bflo(a.y); v[3] = bfhi(a.y); v[4] = bflo(a.z); v[5] = bfhi(a.z); v[6] = bflo(a.w); v[7] = bfhi(a.w);
      v[8] = bflo(bb.x); v[9] = bfhi(bb.x); v[10] = bflo(bb.y); v[11] = bfhi(bb.y); v[12] = bflo(bb.z); v[13] = bfhi(bb.z); v[14] = bflo(bb.w); v[15] = bfhi(bb.w);
      float ss = 0.f;
#pragma unroll
      for (int i = 0; i < 16; ++i) ss += v[i] * v[i];
      ss += __shfl_xor(ss, 1); ss += __shfl_xor(ss, 2);
      const float rn = rsqrtf(ss * (1.0f / 64.0f) + EPS); const float* g = P.in[I_SGUVG] + (layer * 4 + hh) * 64 + dq * 16;
#pragma unroll
      for (int i = 0; i < 16; ++i) VT[(dq * 16 + i) * ST136 + s] = f2bf(v[i] * rn * g[i]); }
    __syncthreads();
    const int tb = wid >> 1, db = wid & 1; f32x16 acc = {};
    for (int ks = 0; ks < 2 * (tb + 1); ++ks) { const bf16x8 a = *(const bf16x8*)(Wt + (32 * tb + r) * ST136 + 16 * ks + 8 * h); const bf16x8 bb = *(const bf16x8*)(VT + (32 * db + r) * ST136 + 16 * ks + 8 * h); acc = MFMA32(a, bb, acc); }
    const float* bs = P.in[I_SGUB] + (layer * 4 + hh) * 128;
#pragma unroll
    for (int i = 0; i < 16; ++i) { const int t = 32 * tb + crow(i, h), d = 32 * db + r; const float uu = bf2f(Z[(row0 + t) * ZP + hh * 64 + d]);
        MIX[(row0 + t) * 1024 + hh * 64 + d] = f2bf(uu * (acc[i] + bs[t])); }
    __syncthreads();
}
DI void load_rot(const bf16* zh, const float* cs, const float* sn, int dq, float scale, float (&o1)[8], float (&o2)[8]) {
    const u32x4 a = *(const u32x4*)(zh + dq * 8), bb = *(const u32x4*)(zh + 32 + dq * 8);
    const f32x4 c0 = *(const f32x4*)(cs + dq * 8), c1 = *(const f32x4*)(cs + dq * 8 + 4), s0 = *(const f32x4*)(sn + dq * 8), s1 = *(const f32x4*)(sn + dq * 8 + 4);
    float x1[8] = {bflo(a.x), bfhi(a.x), bflo(a.y), bfhi(a.y), bflo(a.z), bfhi(a.z), bflo(a.w), bfhi(a.w)};
    float x2[8] = {bflo(bb.x), bfhi(bb.x), bflo(bb.y), bfhi(bb.y), bflo(bb.z), bfhi(bb.z), bflo(bb.w), bfhi(bb.w)};
#pragma unroll
    for (int j = 0; j < 8; ++j) { const float cc = j < 4 ? c0[j & 3] : c1[j & 3], sv = j < 4 ? s0[j & 3] : s1[j & 3];
        o1[j] = (x1[j] * cc - x2[j] * sv) * scale; o2[j] = (x1[j] * sv + x2[j] * cc) * scale; }
}
DI void ret1_unit(const Params& P, float lg, int b, int hh, int c, char* lds) {
    int tid_u = threadIdx.x; asm volatile("" : "+v"(tid_u)); const int tid = tid_u, lane = tid & 63, wid = tid >> 6, r = lane & 31, h = lane >> 5;
    bf16* KT = (bf16*)lds; bf16* VT = KT + 64 * ST136;
    const bf16* Z = (const bf16*)(P.ws + WS_RA); float* ST = (float*)(P.ws + WS_RB + 64 * MiB);
    const size_t row0 = (size_t)b * S + (size_t)c * 128;
    { const int s = tid >> 2, dq = tid & 3; const size_t row = row0 + s; float o1[8], o2[8];
      load_rot(Z + row * ZP + 896 + hh * 64, (const float*)(P.ws + WS_COS) + row * 32, (const float*)(P.ws + WS_SIN) + row * 32, dq, 0.125f * __builtin_amdgcn_exp2f((float)(127 - s) * lg), o1, o2);
#pragma unroll
      for (int j = 0; j < 8; ++j) { KT[(dq * 8 + j) * ST136 + s] = f2bf(o1[j]); KT[(32 + dq * 8 + j) * ST136 + s] = f2bf(o2[j]); }
      const bf16* vp = Z + row * ZP + 1280 + hh * 64 + dq * 16; const u32x4 a = *(const u32x4*)vp, bb = *(const u32x4*)(vp + 8);
      const unsigned vv[8] = {a.x, a.y, a.z, a.w, bb.x, bb.y, bb.z, bb.w};
#pragma unroll
      for (int i = 0; i < 8; ++i) { VT[(dq * 16 + 2 * i) * ST136 + s] = (bf16)(vv[i] & 0xffffu); VT[(dq * 16 + 2 * i + 1) * ST136 + s] = (bf16)(vv[i] >> 16); } }
    __syncthreads();
    if (wid < 4) { const int db = wid >> 1, eb = wid & 1; f32x16 acc = {};
#pragma unroll
        for (int ks = 0; ks < 8; ++ks) { const bf16x8 a = *(const bf16x8*)(KT + (32 * db + r) * ST136 + 16 * ks + 8 * h); const bf16x8 bb = *(const bf16x8*)(VT + (32 * eb + r) * ST136 + 16 * ks + 8 * h); acc = MFMA32(a, bb, acc); }
        float* st = ST + ((size_t)((b * 6 + hh) * NCH + c)) * 4096;
#pragma unroll
        for (int i = 0; i < 16; ++i) st[(32 * db + crow(i, h)) * 64 + 32 * eb + r] = acc[i]; }
    __syncthreads();
}
DI void cum_unit(const Params& P, int b, int c) {
    int tid_u = threadIdx.x; asm volatile("" : "+v"(tid_u)); const int tid = tid_u, lane = tid & 63, wid = tid >> 6;
    if (wid < 6) { const float* LF = (const float*)(P.ws + WS_LF); float* CL = (float*)(P.ws + WS_CL); float* CT = (float*)(P.ws + WS_CT);
        const size_t row = (size_t)b * S + (size_t)c * 128 + 2 * lane; const float v0 = LF[row * 8 + wid], v1 = LF[(row + 1) * 8 + wid];
        float x = v0 + v1;
#pragma unroll
        for (int o = 1; o < 64; o <<= 1) { const float y = __shfl_up(x, o); if (lane >= o) x += y; }
        float* cl = CL + (size_t)(b * 6 + wid) * S + (size_t)c * 128 + 2 * lane; cl[0] = x - v1; cl[1] = x;
        if (lane == 63) CT[(b * 6 + wid) * NCH + c] = x;
        const bf16* Z = (const bf16*)(P.ws + WS_RA); float km = 0.f;
#pragma unroll
        for (int rr = 0; rr < 2; ++rr) { const bf16* kp = Z + (row + rr) * ZP + 2432 + wid * 64; float ss = 0.f;
#pragma unroll
            for (int j = 0; j < 8; ++j) { const u32x4 w = *(const u32x4*)(kp + 8 * j);
                ss += bflo(w.x) * bflo(w.x) + bfhi(w.x) * bfhi(w.x) + bflo(w.y) * bflo(w.y) + bfhi(w.y) * bfhi(w.y) + bflo(w.z) * bflo(w.z) + bfhi(w.z) * bfhi(w.z) + bflo(w.w) * bflo(w.w) + bfhi(w.w) * bfhi(w.w); }
            km = fmaxf(km, ss); }
#pragma unroll
        for (int o = 1; o < 64; o <<= 1) km = fmaxf(km, __shfl_xor(km, o));
        if (lane == 0) ((float*)(P.ws + WS_KN))[(b * 6 + wid) * NCH + c] = km; }
}
DI void ret3_unit(const Params& P, float lg, int b, int hh, int c, char* lds) {
    int tid_u = threadIdx.x; asm volatile("" : "+v"(tid_u)); const int tid = tid_u, lane = tid & 63, wid = tid >> 6, r = lane & 31, h = lane >> 5;
    bf16* Q = (bf16*)lds; bf16* K = Q + 128 * ST72; bf16* VT = K + 128 * ST72; bf16* RT = VT + 64 * ST136; bf16* Pm = RT + 64 * ST72; float* O = (float*)lds;
    const bf16* Z = (const bf16*)(P.ws + WS_RA); bf16* MIX = (bf16*)(P.ws + WS_RB); const float* ST = (const float*)(P.ws + WS_RB + 64 * MiB) + ((size_t)((b * 6 + hh) * NCH + c)) * 4096;
    const size_t row0 = (size_t)b * S + (size_t)c * 128;
    { const int s = tid >> 2, dq = tid & 3; const size_t row = row0 + s; float o1[8], o2[8];
      const float* cs = (const float*)(P.ws + WS_COS) + row * 32; const float* sn = (const float*)(P.ws + WS_SIN) + row * 32;
      load_rot(Z + row * ZP + 512 + hh * 64, cs, sn, dq, 1.0f, o1, o2);
      { u32x4 w; w.x = pk2(o1[0], o1[1]); w.y = pk2(o1[2], o1[3]); w.z = pk2(o1[4], o1[5]); w.w = pk2(o1[6], o1[7]); *(u32x4*)(Q + s * ST72 + dq * 8) = w;
        w.x = pk2(o2[0], o2[1]); w.y = pk2(o2[2], o2[3]); w.z = pk2(o2[4], o2[5]); w.w = pk2(o2[6], o2[7]); *(u32x4*)(Q + s * ST72 + 32 + dq * 8) = w; }
      load_rot(Z + row * ZP + 896 + hh * 64, cs, sn, dq, 0.125f, o1, o2);
      { u32x4 w; w.x = pk2(o1[0], o1[1]); w.y = pk2(o1[2], o1[3]); w.z = pk2(o1[4], o1[5]); w.w = pk2(o1[6], o1[7]); *(u32x4*)(K + s * ST72 + dq * 8) = w;
        w.x = pk2(o2[0], o2[1]); w.y = pk2(o2[2], o2[3]); w.z = pk2(o2[4], o2[5]); w.w = pk2(o2[6], o2[7]); *(u32x4*)(K + s * ST72 + 32 + dq * 8) = w; }
      const bf16* vp = Z + row * ZP + 1280 + hh * 64 + dq * 16; const u32x4 a = *(const u32x4*)vp, bb = *(const u32x4*)(vp + 8);
      const unsigned vv[8] = {a.x, a.y, a.z, a.w, bb.x, bb.y, bb.z, bb.w};
#pragma unroll
      for (int i = 0; i < 8; ++i) { VT[(dq * 16 + 2 * i) * ST136 + s] = (bf16)(vv[i] & 0xffffu); VT[(dq * 16 + 2 * i + 1) * ST136 + s] = (bf16)(vv[i] >> 16); }
      const int d = tid >> 3, e0 = (tid & 7) * 8; const f32x4 r0 = *(const f32x4*)(ST + d * 64 + e0), r1 = *(const f32x4*)(ST + d * 64 + e0 + 4);
#pragma unroll
      for (int i = 0; i < 4; ++i) { RT[(e0 + i) * ST72 + d] = f2bf(r0[i]); RT[(e0 + 4 + i) * ST72 + d] = f2bf(r1[i]); } }
    __syncthreads();
    for (int blk = wid; blk < 10; blk += 8) {
        const int tb = blk < 1 ? 0 : blk < 3 ? 1 : blk < 6 ? 2 : 3, sb = blk - (tb * (tb + 1)) / 2; f32x16 acc = {};
#pragma unroll
        for (int ks = 0; ks < 4; ++ks) { const bf16x8 a = *(const bf16x8*)(Q + (32 * tb + r) * ST72 + 16 * ks + 8 * h); const bf16x8 bb = *(const bf16x8*)(K + (32 * sb + r) * ST72 + 16 * ks + 8 * h); acc = MFMA32(a, bb, acc); }
#pragma unroll
        for (int i = 0; i < 16; ++i) { const int t = 32 * tb + crow(i, h), s = 32 * sb + r; const float v = s <= t ? acc[i] * __builtin_amdgcn_exp2f((float)(t - s) * lg) : 0.f; Pm[t * ST136 + s] = f2bf(v); }
    }
    __syncthreads();
    const int tb = wid >> 1, eb = wid & 1; f32x16 a1 = {}, a2 = {};
    for (int ks = 0; ks < 2 * (tb + 1); ++ks) { const bf16x8 a = *(const bf16x8*)(Pm + (32 * tb + r) * ST136 + 16 * ks + 8 * h); const bf16x8 bb = *(const bf16x8*)(VT + (32 * eb + r) * ST136 + 16 * ks + 8 * h); a1 = MFMA32(a, bb, a1); }
#pragma unroll
    for (int ks = 0; ks < 4; ++ks) { const bf16x8 a = *(const bf16x8*)(Q + (32 * tb + r) * ST72 + 16 * ks + 8 * h); const bf16x8 bb = *(const bf16x8*)(RT + (32 * eb + r) * ST72 + 16 * ks + 8 * h); a2 = MFMA32(a, bb, a2); }
    __syncthreads();
#pragma unroll
    for (int i = 0; i < 16; ++i) { const int t = 32 * tb + crow(i, h); O[t * 65 + 32 * eb + r] = a1[i] + a2[i] * __builtin_amdgcn_exp2f((float)(t + 1) * lg); }
    __syncthreads();
    { const int t = tid >> 2, eq = tid & 3; float v[16]; float ss = 0.f;
#pragma unroll
      for (int i = 0; i < 16; ++i) { v[i] = O[t * 65 + eq * 16 + i]; ss += v[i] * v[i]; }
      ss += __shfl_xor(ss, 1); ss += __shfl_xor(ss, 2);
      const float rn = rsqrtf(ss * (1.0f / 64.0f) + EPS); const size_t row = row0 + t;
      const bf16* gp = Z + row * ZP + 1664 + hh * 64 + eq * 16; const u32x4 ga = *(const u32x4*)gp, gb = *(const u32x4*)(gp + 8);
      const unsigned gg[8] = {ga.x, ga.y, ga.z, ga.w, gb.x, gb.y, gb.z, gb.w}; unsigned ow[8];
#pragma unroll
      for (int i = 0; i < 8; ++i) { const float g0 = bflo(gg[i]), g1 = bfhi(gg[i]);
          ow[i] = pk2(g0 * pg8::sigmoid_f(g0) * v[2 * i] * rn, g1 * pg8::sigmoid_f(g1) * v[2 * i + 1] * rn); }
      bf16* op = MIX + row * 1024 + 256 + hh * 64 + eq * 16;
      *(u32x4*)op = (u32x4){ow[0], ow[1], ow[2], ow[3]}; *(u32x4*)(op + 8) = (u32x4){ow[4], ow[5], ow[6], ow[7]}; }
    __syncthreads();
}
DI void fox_unit(const Params& P, int b, int hh, int qb, char* lds) {
    int tid_u = threadIdx.x; asm volatile("" : "+v"(tid_u)); const int tid = tid_u, lane = tid & 63, wid = tid >> 6, r = lane & 31, h = lane >> 5;
    bf16* Kt = (bf16*)lds; bf16* VT = Kt + 2 * 64 * ST72; float* NC = (float*)(VT + 2 * 64 * ST68);
    const bf16* Z = (const bf16*)(P.ws + WS_RA); bf16* MIX = (bf16*)(P.ws + WS_RB);
    const size_t rowb = (size_t)b * S; const int q0 = qb * 256;
    const float* c2 = (const float*)(P.ws + WS_C2) + (size_t)(b * 6 + hh) * S; const float cref = c2[q0];
    const int qrow = q0 + 32 * wid + r;
    bf16x8 qf[4];
    { const bf16* qp = Z + (rowb + qrow) * ZP + 2048 + hh * 64; const float sc = 0.125f * LOG2E;
#pragma unroll
      for (int s = 0; s < 4; ++s) { const u32x4 w = *(const u32x4*)(qp + 16 * s + 8 * h); u32x4 o;
          o.x = pk2(bflo(w.x) * sc, bfhi(w.x) * sc); o.y = pk2(bflo(w.y) * sc, bfhi(w.y) * sc); o.z = pk2(bflo(w.z) * sc, bfhi(w.z) * sc); o.w = pk2(bflo(w.w) * sc, bfhi(w.w) * sc);
          qf[s] = __builtin_bit_cast(bf16x8, o); } }
    float qn;
    { float ss = 0.f;
#pragma unroll
      for (int s = 0; s < 4; ++s) { const u32x4 w = __builtin_bit_cast(u32x4, qf[s]);
          ss += bflo(w.x) * bflo(w.x) + bfhi(w.x) * bfhi(w.x) + bflo(w.y) * bflo(w.y) + bfhi(w.y) * bfhi(w.y) + bflo(w.z) * bflo(w.z) + bfhi(w.z) * bfhi(w.z) + bflo(w.w) * bflo(w.w) + bfhi(w.w) * bfhi(w.w); }
      ss += __shfl_xor(ss, 32);
#pragma unroll
      for (int o = 1; o < 32; o <<= 1) ss = fmaxf(ss, __shfl_xor(ss, o));
      qn = sqrtf(ss) * 1.001f; }
    const float* kpms = (const float*)(P.ws + WS_KPMS) + (b * 6 + hh) * NCH;
    volatile unsigned* dflag = (volatile unsigned*)(NC + 128);
    if (tid < 8) dflag[tid] = 0u;
    bool done = false;
    f32x16 o0 = {}, o1 = {}; float m = -INFINITY, l = 0.f;
    const int ntile = 4 * (qb + 1);
    const int lrow = tid >> 3, lch = tid & 7;
    const bf16* kg = Z + (rowb + lrow) * ZP + 2432 + hh * 64 + lch * 8; const bf16* vg = Z + (rowb + lrow) * ZP + 2816 + hh * 64 + lch * 8;
    u32x4 kreg, vreg; float ncreg = 0.f;
#define FOX_LOAD(t) do { kreg = *(const u32x4*)(kg + (size_t)(t) * 64 * ZP); vreg = *(const u32x4*)(vg + (size_t)(t) * 64 * ZP); if (tid < 64) ncreg = cref - c2[64 * (t) + tid]; } while (0)
#define FOX_STORE(bufi) do { *(u32x4*)(Kt + (bufi) * 64 * ST72 + lrow * ST72 + lch * 8) = kreg; bf16* vt_ = VT + (bufi) * 64 * ST68 + (lch * 8) * ST68 + lrow; \
        vt_[0] = (bf16)(vreg.x & 0xffffu); vt_[ST68] = (bf16)(vreg.x >> 16); vt_[2 * ST68] = (bf16)(vreg.y & 0xffffu); vt_[3 * ST68] = (bf16)(vreg.y >> 16); \
        vt_[4 * ST68] = (bf16)(vreg.z & 0xffffu); vt_[5 * ST68] = (bf16)(vreg.z >> 16); vt_[6 * ST68] = (bf16)(vreg.w & 0xffffu); vt_[7 * ST68] = (bf16)(vreg.w >> 16); \
        if (tid < 64) NC[(bufi) * 64 + tid] = ncreg; } while (0)
    FOX_LOAD(ntile - 1); FOX_STORE(0); __syncthreads();
    int buf = 0;
    for (int t = ntile - 1; t >= 0; --t) {
        float c2n = 0.f, kpn = 0.f;
        if (t > 0) { FOX_LOAD(t - 1); c2n = c2[64 * t - 1]; kpn = kpms[(t - 1) >> 1]; }
        const int kv0 = 64 * t;
        if (!done && kv0 <= q0 + 32 * wid + 31) {
            const bf16* Kb = Kt + buf * 64 * ST72; const bf16* Vb = VT + buf * 64 * ST68; const float* NCb = NC + buf * 64;
            f32x16 p0 = {}, p1 = {};
#pragma unroll
            for (int s = 0; s < 4; ++s) { const bf16x8 a0 = *(const bf16x8*)(Kb + r * ST72 + 16 * s + 8 * h), a1 = *(const bf16x8*)(Kb + (32 + r) * ST72 + 16 * s + 8 * h);
                p0 = MFMA32(a0, qf[s], p0); p1 = MFMA32(a1, qf[s], p1); }
#pragma unroll
            for (int g = 0; g < 4; ++g) { const f32x4 n0 = *(const f32x4*)(NCb + 8 * g + 4 * h), n1 = *(const f32x4*)(NCb + 32 + 8 * g + 4 * h);
#pragma unroll
                for (int j = 0; j < 4; ++j) { p0[4 * g + j] += n0[j]; p1[4 * g + j] += n1[j]; } }
            if (kv0 + 63 > q0 + 32 * wid) {
#pragma unroll
                for (int i = 0; i < 16; ++i) { const int kv = kv0 + crow(i, h); if (kv > qrow) p0[i] = -INFINITY; if (kv + 32 > qrow) p1[i] = -INFINITY; } }
            float mx = fmaxf(p0[0], p1[0]);
#pragma unroll
            for (int i = 1; i < 16; ++i) mx = fmaxf(mx, fmaxf(p0[i], p1[i]));
            mx = fmaxf(mx, __shfl_xor(mx, 32));
            const float mn = fmaxf(m, mx), mu = (mn == -INFINITY) ? 0.f : mn; const float alpha = __builtin_amdgcn_exp2f(m - mu); m = mn;
            float ls = 0.f;
#pragma unroll
            for (int i = 0; i < 16; ++i) { p0[i] = __builtin_amdgcn_exp2f(p0[i] - mu); p1[i] = __builtin_amdgcn_exp2f(p1[i] - mu); ls += p0[i] + p1[i]; }
            l = l * alpha + ls;
#pragma unroll
            for (int i = 0; i < 16; ++i) { o0[i] *= alpha; o1[i] *= alpha; }
#pragma unroll
            for (int blk = 0; blk < 2; ++blk)
#pragma unroll
                for (int s = 0; s < 2; ++s) { const bf16x8 pf = blk == 0 ? pack8(p0, 8 * s) : pack8(p1, 8 * s); const int kvo = 32 * blk + 16 * s + 4 * h;
                    const u32x2 l0 = *(const u32x2*)(Vb + r * ST68 + kvo), h0 = *(const u32x2*)(Vb + r * ST68 + kvo + 8);
                    const u32x2 l1 = *(const u32x2*)(Vb + (32 + r) * ST68 + kvo), h1 = *(const u32x2*)(Vb + (32 + r) * ST68 + kvo + 8);
                    const u32x4 v0 = {l0.x, l0.y, h0.x, h0.y}, v1 = {l1.x, l1.y, h1.x, h1.y};
                    o0 = MFMA32(__builtin_bit_cast(bf16x8, v0), pf, o0); o1 = MFMA32(__builtin_bit_cast(bf16x8, v1), pf, o1); }
            if (t > 0) { float mm = m;
#pragma unroll
                for (int o = 1; o < 32; o <<= 1) mm = fminf(mm, __shfl_xor(mm, o));
                const float mmu = __uint_as_float(__builtin_amdgcn_readfirstlane(__float_as_uint(mm)));
                if (qn * kpn + (cref - c2n) < mmu - 40.0f) done = true; }
        }
        if (t > 0) FOX_STORE(buf ^ 1);
        if (done && lane == 0) dflag[wid] = 1u;
        __syncthreads();
        buf ^= 1;
        if ((dflag[0] & dflag[1] & dflag[2] & dflag[3] & dflag[4] & dflag[5] & dflag[6] & dflag[7]) != 0u) break;
    }
#undef FOX_LOAD
#undef FOX_STORE
    l += __shfl_xor(l, 32); const float inv = 1.0f / l;
    bf16* op = MIX + (rowb + qrow) * 1024 + 640 + hh * 64;
#pragma unroll
    for (int g = 0; g < 4; ++g) { u32x2 w; w.x = pk2(o0[4 * g] * inv, o0[4 * g + 1] * inv); w.y = pk2(o0[4 * g + 2] * inv, o0[4 * g + 3] * inv); *(u32x2*)(op + 8 * g + 4 * h) = w;
        w.x = pk2(o1[4 * g] * inv, o1[4 * g + 1] * inv); w.y = pk2(o1[4 * g + 2] * inv, o1[4 * g + 3] * inv); *(u32x2*)(op + 32 + 8 * g + 4 * h) = w; }
}
#ifndef PMASK
#define PMASK 0xffff
#endif
#define PEN(k) ((PMASK >> (k)) & 1)
#ifndef DUP
#define DUP 0
#endif
#ifndef XSYNC
#define XSYNC 0
#endif
#define REP(k) for (int rep_ = 0; rep_ < 1 + ((DUP >> (k)) & 1); ++rep_)
constexpr int LDS_BYTES = 147456;
constexpr int LDS_QW = 140 * 1024;
#define LAS __attribute__((address_space(3)))
#define XB_TMO      128
#define XB_XCNT(j)  (256  + 64 * (j))
#define XB_XSUB(j)  (1280 + 64 * (j))
#define XB_XGEN(j)  (2304 + 64 * (j))
#define XB_TOP      3328
#define XB_TOPGEN   3392
#define XCD_BAR_WORDS 3456
#define XB_SPIN_CAP (1u << 18)

__device__ __forceinline__ unsigned xb_ld(unsigned* p)              { return __hip_atomic_load(p, __ATOMIC_RELAXED, __HIP_MEMORY_SCOPE_AGENT); }
__device__ __forceinline__ unsigned xb_add(unsigned* p, unsigned v) { return __hip_atomic_fetch_add(p, v, __ATOMIC_RELAXED, __HIP_MEMORY_SCOPE_AGENT); }
__device__ __forceinline__ unsigned xb_xcc_id() { return (unsigned)__builtin_amdgcn_s_getreg((3 << 11) | 20) & 0xFu; }
#define XB_SPIN(cond, bar) do { unsigned _sp = 0; while (cond) { __builtin_amdgcn_s_sleep(1); \
    if ((++_sp & 255u) == 0u) { if (xb_ld(&(bar)[XB_TMO])) break; if (_sp > XB_SPIN_CAP) { atomicAdd(&(bar)[XB_TMO], 1u); break; } } } } while (0)

struct XcdBarrier {
    unsigned* bar; unsigned x;
    volatile LAS unsigned* st;
};

__device__ __forceinline__ XcdBarrier xcd_barrier_post(unsigned* bar, volatile LAS unsigned* st) {
    XcdBarrier b; b.bar = bar; b.x = xb_xcc_id(); b.st = st;
    if (threadIdx.x == 0) (void)xb_add(&bar[XB_XCNT(b.x)], 1u);
    return b;
}
__device__ __forceinline__ void xcd_barrier_complete(unsigned* bar, unsigned x, unsigned& nloc, unsigned& nx) {
    const unsigned G = gridDim.x * gridDim.y * gridDim.z;
    unsigned sum, cnt, mine, sp = 0u;
    for (;;) {
        sum = 0u; cnt = 0u; mine = 0u;
#pragma unroll
        for (unsigned j = 0; j < 16; ++j) { const unsigned c = xb_ld(&bar[XB_XCNT(j)]); sum += c; cnt += (c > 0u) ? 1u : 0u; mine = (j == x) ? c : mine; }
        if (sum == G) break;
        __builtin_amdgcn_s_sleep(1);
        if ((++sp & 255u) == 0u) { if (xb_ld(&bar[XB_TMO])) break; if (sp > XB_SPIN_CAP) { atomicAdd(&bar[XB_TMO], 1u); break; } }
    }
    nloc = mine > 0u ? mine : 1u; nx = cnt > 0u ? cnt : 1u;
}

__device__ __forceinline__ void xcd_barrier(const XcdBarrier& b) {
    asm volatile("s_waitcnt vmcnt(0)" ::: "memory");
    __syncthreads();
    if (threadIdx.x == 0) {
        unsigned* bar = b.bar;
        __builtin_amdgcn_s_waitcnt(0);
        unsigned nloc = b.st[0], nx = b.st[1];
        if (nloc == 0u) { xcd_barrier_complete(bar, b.x, nloc, nx); b.st[0] = nloc; b.st[1] = nx; }
        const unsigned old = xb_add(&bar[XB_XSUB(b.x)], 1u);
        const unsigned gen = old / nloc;
        if (old + 1u == (gen + 1u) * nloc) {
            __builtin_amdgcn_fence(__ATOMIC_RELEASE, "agent");
            asm volatile("s_waitcnt vmcnt(0)" ::: "memory");
            const unsigned og = xb_add(&bar[XB_TOP], 1u);
            const unsigned tg = og / nx;
            if (og + 1u == (tg + 1u) * nx) xb_add(&bar[XB_TOPGEN], 1u);
            else XB_SPIN(xb_ld(&bar[XB_TOPGEN]) == tg, bar);
            __builtin_amdgcn_fence(__ATOMIC_ACQUIRE, "agent");
            xb_add(&bar[XB_XGEN(b.x)], 1u);
            asm volatile("s_waitcnt vmcnt(0)" ::: "memory");
        } else {
            XB_SPIN(xb_ld(&bar[XB_XGEN(b.x)]) == gen, bar);
            __builtin_amdgcn_fence(__ATOMIC_ACQUIRE, "agent");
            asm volatile("s_waitcnt vmcnt(0)" ::: "memory");
        }
    }
    __syncthreads();
}

constexpr int CW_BAR = 4096;
constexpr int LDS_MISC = 141 * 1024;
typedef const __attribute__((address_space(4))) Params* kparams_t;
#if defined(__HIP_DEVICE_COMPILE__)
#define PH_COPY const Params P = *pp_;
#else
#define PH_COPY const Params P = Pk; const Params* pp_h = &Pk; (void)pp_h;
#endif
#define PH_BEGIN  kparams_t pp_ = (kparams_t)__builtin_amdgcn_kernarg_segment_ptr(); asm volatile("" : "+s"(pp_)); PH_COPY \
    int tid_ = threadIdx.x; asm volatile("" : "+v"(tid_)); const int tid = tid_, lane = tid & 63, wave = __builtin_amdgcn_readfirstlane(tid >> 6); \
    const int G = gridDim.x, bx = blockIdx.x, gw = bx * 8 + wave, NGW = G * 8; unsigned char* ws = P.ws; (void)lane; (void)gw; (void)NGW; (void)ws; \
    PG8_LAS unsigned char* L = (PG8_LAS unsigned char*)lds; (void)L;
#define GRID_SYNC() do { kparams_t pg_ = (kparams_t)__builtin_amdgcn_kernarg_segment_ptr(); XcdBarrier xb_; xb_.bar = (unsigned*)(pg_->ws + WS_CTL) + CW_BAR; xb_.x = xb_xcc_id(); \
    xb_.st = (volatile LAS unsigned*)((LAS unsigned char*)lds + LDS_MISC); xcd_barrier(xb_); } while (0)
#define WSP(T_, off) ((T_*)(ws + (off)))
__global__ void __launch_bounds__(512, 2) fwd_kernel(Params Pk) {
    extern __shared__ __attribute__((aligned(16))) unsigned char lds[];
    cg::grid_group grid = cg::this_grid();
    { volatile LAS unsigned* st = (volatile LAS unsigned*)((LAS unsigned char*)lds + LDS_MISC);
      if (threadIdx.x < 2) st[threadIdx.x] = 0u;
      __syncthreads();
      kparams_t pq_ = (kparams_t)__builtin_amdgcn_kernarg_segment_ptr();
      (void)xcd_barrier_post((unsigned*)(pq_->ws + WS_CTL) + CW_BAR, st); }
    { PH_BEGIN
      convert_weights(P, 0, (char*)lds, gw, NGW, wave, lane);
      rope_table(P, bx * 512 + tid, G * 512);
      resid_rows(P, P.in[I_X], nullptr, nullptr, nullptr, gw, NGW, lane); }
    asm volatile("s_waitcnt vmcnt(0) lgkmcnt(0)" ::: "memory"); grid.sync(); __builtin_amdgcn_fence(__ATOMIC_ACQUIRE, "agent"); asm volatile("s_waitcnt vmcnt(0)" ::: "memory");
    for (int layer = 0; layer < DEPTH; ++layer) {
        if (PEN(1)) REP(1) { PH_BEGIN
          pg8::Gemm g{WSP(bf16, WS_XB), WSP(const bf16, WS_W + W_IN), T, ZP, 1024}; pg8::StaticOrder So; So.init(T, ZP, G, bx);
          pg8::EpiZ E{WSP(bf16, WS_RA), WSP(float, WS_RINVX), WSP(float, WS_LF), P.in[I_FOXB] + layer * 6};
          pg8::gemm_phase<pg8::EpiZ, pg8::StaticOrder, true, true>(L, g, So, E); }
        GRID_SYNC();
        if (PEN(2)) REP(2) { PH_BEGIN
          for (int u = bx; u < 1024 + 1536 + 256; u += G) {
            if (u < 1024) { sgu_unit(P, layer, u >> 9, (u >> 2) & 127, u & 3, (char*)lds); }
            else if (u < 2560) { const int v = u - 1024, bh = v / NCH, c = v % NCH; ret1_unit(P, pp_->lg2gam[bh % 6], bh / 6, bh % 6, c, (char*)lds); }
            else { const int v = u - 2560; cum_unit(P, v >> 7, v & 127); } } }
        GRID_SYNC();
        if (PEN(3)) { PH_BEGIN
          float* ST = (float*)(ws + WS_RB + 64 * MiB);
          for (int e = bx * 512 + tid; e < 12 * 4096; e += G * 512) { const int bh = e >> 12, de = e & 4095; const float g128 = __builtin_amdgcn_exp2f(128.0f * pp_->lg2gam[bh % 6]);
              float* p = ST + (size_t)bh * NCH * 4096 + de; float carry = 0.f;
              for (int c0 = 0; c0 < NCH; c0 += 32) { float sv[32];
#pragma unroll
                  for (int j = 0; j < 32; ++j) sv[j] = p[(size_t)(c0 + j) * 4096];
#pragma unroll
                  for (int j = 0; j < 32; ++j) { p[(size_t)(c0 + j) * 4096] = carry; carry = carry * g128 + sv[j]; } } }
          if (bx >= G - 12) { const int bh = bx - (G - 12);
              const float* CT = (const float*)(ws + WS_CT); const float* CL = (const float*)(ws + WS_CL); float* C2 = (float*)(ws + WS_C2); const float* KN = (const float*)(ws + WS_KN);
              float* pre = (float*)lds;
              if (tid < 128) { const float v = CT[bh * NCH + tid]; float x = v, km = KN[bh * NCH + tid];
#pragma unroll
                  for (int o = 1; o < 64; o <<= 1) { const float y = __shfl_up(x, o), z = __shfl_up(km, o); if (lane >= o) { x += y; km = fmaxf(km, z); } }
                  pre[tid] = x - v; pre[128 + tid] = x; pre[256 + tid] = km; }
              __syncthreads();
              if (tid >= 64 && tid < 128) { pre[tid] += pre[128 + 63]; pre[256 + tid] = fmaxf(pre[256 + tid], pre[256 + 63]); }
              __syncthreads();
              if (tid < 128) ((float*)(ws + WS_KPMS))[bh * NCH + tid] = sqrtf(pre[256 + tid]);
              for (int i = tid; i < S; i += 512) C2[(size_t)bh * S + i] = (pre[i >> 7] + CL[(size_t)bh * S + i]) * LOG2E;
              __syncthreads(); } }
        GRID_SYNC();
        if (PEN(4)) REP(4) { PH_BEGIN
          unsigned* qctr = WSP(unsigned, WS_CTL) + 64 * (1 + layer) + 256 * rep_; volatile unsigned* qw = (volatile unsigned*)(lds + LDS_QW);
          for (;;) { if (tid == 0) *qw = atomicAdd(qctr, 1u);
              __syncthreads(); const unsigned u = *qw; __syncthreads();
              if (u >= 768u + 1536u) break;
              if (u < 768u) { const int qb = 63 - (int)(u / 12u), bh = (int)(u % 12u); fox_unit(P, bh / 6, bh % 6, qb, (char*)lds); }
              else { const int v = (int)u - 768, bh = v / NCH, c = v % NCH; ret3_unit(P, pp_->lg2gam[bh % 6], bh / 6, bh % 6, c, (char*)lds); } } }
        GRID_SYNC();
        if (PEN(5)) REP(5) { PH_BEGIN
          pg8::Gemm g{WSP(bf16, WS_RB), WSP(const bf16, WS_W + W_O), T, 1024, 1024}; pg8::StaticOrder So; So.init(T, 1024, G, bx);
          pg8::EpiY E{WSP(bf16, WS_RA), WSP(float, WS_SSQP), 1024}; pg8::gemm_phase<pg8::EpiY, pg8::StaticOrder, true, true>(L, g, So, E); }
        GRID_SYNC();
        { PH_BEGIN
          resid_rows(P, layer == 0 ? P.in[I_X] : P.out, P.out, WSP(bf16, WS_RA), P.in[I_MIXPOST] + layer * 1024, gw, NGW, lane); }
        GRID_SYNC();
        if (PEN(7)) for (int st = 0; st < 5; ++st) { REP(7) {
            if (st == 2 || st == 4) { PH_BEGIN
                const int hb = (st - 2) >> 1;
                pg8::Gemm g{WSP(bf16, WS_RA) + (size_t)S * DFF, WSP(const bf16, WS_W + W_D), S, 1024, DFF}; pg8::StaticOrder So; So.init(S, 1024, G, bx);
                pg8::EpiY E{WSP(bf16, WS_RB) + (size_t)hb * S * 1024, WSP(float, WS_SSQP) + (size_t)hb * S * 16, 1024}; pg8::gemm_phase<pg8::EpiY, pg8::StaticOrder, true, true>(L, g, So, E); }
            if (st == 0 || st == 2) { PH_BEGIN
                const int hb = st >> 1;
                pg8::Gemm g{WSP(bf16, WS_XB) + (size_t)hb * S * 1024, WSP(const bf16, WS_W + W_G), S, DFF, 1024}; pg8::StaticOrder So; So.init(S, DFF, G, bx);
                pg8::EpiS E{WSP(bf16, WS_RA), WSP(float, WS_RINVX) + hb * S, DFF}; pg8::gemm_phase<pg8::EpiS, pg8::StaticOrder, true, true>(L, g, So, E); }
            if (st == 1 || st == 3) { PH_BEGIN
                const int hb = st >> 1;
                pg8::Gemm g{WSP(bf16, WS_XB) + (size_t)hb * S * 1024, WSP(const bf16, WS_W + W_U), S, DFF, 1024}; pg8::StaticOrder So; So.init(S, DFF, G, bx);
                pg8::EpiAct E{WSP(bf16, WS_RA) + (size_t)S * DFF, WSP(const bf16, WS_RA), WSP(float, WS_RINVX) + hb * S, P.in[I_CONVW] + (size_t)layer * 3 * DFF, P.in[I_CONVB] + (size_t)layer * DFF};
                pg8::gemm_phase<pg8::EpiAct, pg8::StaticOrder, true, true>(L, g, So, E); }
            }
            GRID_SYNC();
        }
        if (PEN(10)) REP(10) { PH_BEGIN
          int kd_ = 256; asm volatile("" : "+s"(kd_));
          pg8::Gemm g{WSP(const bf16, WS_PB), WSP(const bf16, WS_W + W_PP), T, 1024, kd_}; pg8::StaticOrder So; So.init(T, 1024, G, bx);
          pg8::EpiS E{WSP(bf16, WS_RA), nullptr, 1024}; pg8::gemm_phase<pg8::EpiS, pg8::StaticOrder, true, true>(L, g, So, E); }
        { PH_BEGIN
          resid_rows(P, P.out, P.out, WSP(bf16, WS_RB), P.in[I_FFNPOST] + layer * 1024, gw, NGW, lane); }
        GRID_SYNC();
        if (PEN(11)) REP(11) { PH_BEGIN
          pg8::Gemm g{WSP(bf16, WS_XB), WSP(const bf16, WS_W + W_PG), T, 1024, 1024}; pg8::StaticOrder So; So.init(T, 1024, G, bx);
          pg8::EpiPle E{WSP(bf16, WS_RB), WSP(const bf16, WS_RA), WSP(float, WS_RINVX), WSP(float, WS_SSQP)}; pg8::gemm_phase<pg8::EpiPle, pg8::StaticOrder, true, true>(L, g, So, E); }
        GRID_SYNC();
        { PH_BEGIN
          resid_rows(P, P.out, P.out, WSP(bf16, WS_RB), P.in[I_PLEPOST] + layer * 1024, gw, NGW, lane);
          if (layer + 1 < DEPTH) { __syncthreads(); convert_weights(P, layer + 1, (char*)lds, gw, NGW, wave, lane); } }
        if (layer + 1 < DEPTH) GRID_SYNC();
        for (int xs_ = 0; xs_ < XSYNC; ++xs_) GRID_SYNC();
    }
}

extern "C" void kernel_launch(void* const* d_in, const int* in_sizes, int n_in, void* d_out, int out_size, void* d_ws, size_t ws_size, hipStream_t stream) {
    static int grid = 0;
    if (grid == 0) {
        if (n_in != N_INPUTS || ws_size < WS_END) { fprintf(stderr, "kernel_launch: unexpected n_in %d / ws_size %zu\n", n_in, ws_size); grid = -1; return; }
        int dev = 0, cus = 0, per_cu = 0;
        (void)hipGetDevice(&dev); (void)hipDeviceGetAttribute(&cus, hipDeviceAttributeMultiprocessorCount, dev);
        (void)hipFuncSetAttribute((const void*)fwd_kernel, hipFuncAttributeMaxDynamicSharedMemorySize, LDS_BYTES);
        (void)hipOccupancyMaxActiveBlocksPerMultiprocessor(&per_cu, (const void*)fwd_kernel, 512, LDS_BYTES);
        if (per_cu < 1) { fprintf(stderr, "kernel_launch: occupancy query says %d blocks/CU\n", per_cu); per_cu = 1; }
        grid = cus;
    }
    if (grid < 0) return;
    (void)hipMemsetAsync((char*)d_ws + WS_CTL, 0, 65536, stream);
    Params p; memset(&p, 0, sizeof(p));
    for (int i = 0; i < N_INPUTS; ++i) p.in[i] = (const float*)d_in[i];
    p.out = (float*)d_out; p.ws = (unsigned char*)d_ws;
    for (int h = 0; h < 6; ++h) p.lg2gam[h] = (float)log2(1.0 - exp2(-5.0 - (double)h));
    void* args[] = {&p};
    hipError_t e = hipLaunchCooperativeKernel((const void*)fwd_kernel, dim3(grid), dim3(512), args, LDS_BYTES, stream);
    if (e != hipSuccess) fprintf(stderr, "cooperative launch failed: %s (grid %d)\n", hipGetErrorString(e), grid);
}
```

```cpp
#include <hip/hip_runtime.h>
#include <hip/hip_cooperative_groups.h>
#include <cstdio>
#include <cstdint>
#include <cmath>
#include <cstring>
namespace cg = cooperative_groups;
namespace pg8 {
#define PG8_LAS __attribute__((address_space(3)))
typedef unsigned short bf16_t;
typedef short bf16x8 __attribute__((ext_vector_type(8)));
typedef float f32x4 __attribute__((ext_vector_type(4)));
typedef unsigned u32x4 __attribute__((ext_vector_type(4)));
constexpr int BM = 256, BK = 64, HALF = 128, HTB = HALF * BK * 2  , STAGE_BYTES = 8 * HTB, NXCD = 8, WGM = 8;

__host__ __device__ __forceinline__ int lds_byte(int r, int c) { const int st = (r >> 4) * 2 + (c >> 5), rr = r & 15, cc = c & 31, ob = rr * 64 + cc * 2; return st * 1024 + (ob ^ (((ob >> 9) & 1) << 5)); }
__host__ __device__ __forceinline__ void stage_rc(int b, int& R, int& C) { const int st = b / 1024, sb = b % 1024, swz = sb ^ (((sb >> 9) & 1) << 5); R = (st >> 1) * 16 + swz / 64; C = (st & 1) * 32 + (swz % 64) / 2; }
__host__ __device__ __forceinline__ int perm32(int rho) { const int n = rho >> 4, i = rho & 15; return 8 * (i >> 2) + 4 * n + (i & 3); }

struct Unit { int pm, pn; };
struct Gemm { const bf16_t* A; const bf16_t* Bt; int M, N, K; };

struct StaticOrder {
    int nM, nN, nwg, G, c;
    __host__ __device__ void init(int M, int N, int G_, int c_) { nM = M / BM; nN = N / BM; nwg = nM * nN; G = G_; c = c_; }
    __host__ __device__ bool next(int i, Unit& u) const {
        const long L = (long)i * G + c; if (L >= nwg) return false;
        int wgid = (int)L; { const int q = nwg / NXCD, r = nwg % NXCD, xcd = wgid % NXCD, off = wgid / NXCD; wgid = (xcd < r ? xcd * (q + 1) : r * (q + 1) + (xcd - r) * q) + off; }
        const int nig = WGM * nN, gid = wgid / nig, fm = gid * WGM, gsz = (nM - fm) < WGM ? (nM - fm) : WGM;
        u.pm = fm + ((wgid % nig) % gsz); u.pn = (wgid % nig) / gsz; return true;
    }
    __device__ __forceinline__ void a_ready(const Unit&) const {}
    __device__ __forceinline__ void done(const Unit&) const {}
};

__device__ __forceinline__ unsigned cvt_pk_bf16(float lo, float hi) { unsigned r; asm volatile("v_cvt_pk_bf16_f32 %0, %1, %2" : "=v"(r) : "v"(lo), "v"(hi)); return r; }
typedef float f32x2 __attribute__((ext_vector_type(2)));
__device__ __forceinline__ f32x2 gelu_pk(f32x2 v) {
    const f32x2 av = __builtin_elementwise_abs(v), d = av * 0.2316418882f + 1.0f;
    f32x2 t; t.x = __builtin_amdgcn_rcpf(d.x); t.y = __builtin_amdgcn_rcpf(d.y);
    f32x2 q = t * 0.5307027145f + (-0.7265760135f); q = q * t + 0.7107068705f; q = q * t + (-0.142248368f); q = q * t + 0.127414796f; q = q * t;
    const f32x2 s = (v * v) * (-0.72134752044f);
    f32x2 e; e.x = __builtin_amdgcn_exp2f(s.x); e.y = __builtin_amdgcn_exp2f(s.y);
    const f32x2 m = v * (q * e), r = v - m;
    f32x2 o; o.x = v.x < 0.f ? m.x : r.x; o.y = v.y < 0.f ? m.y : r.y; return o;
}

template <int ACT  > struct EpiBf16 {
    static constexpr bool PERM = true, AFTER_DRAIN = false; static_assert(ACT == 0 || ACT == 1, "EpiBf16: ACT is 0 (none) or 1 (gelu_pk)");
    bf16_t* O; int ldc; const float* bias; int split_cols; size_t split_stride; float scale0;
    __device__ __forceinline__ void operator()(const f32x4 (&acc)[2][2][4][2], const Unit& u, int wr, int wc, int fr, int fq) const {
        const int row0 = u.pm * BM + wr * 64 + fr; int colt = u.pn * BM; bf16_t* base = O;
        float sc = 1.f; if (split_cols) { const int t = colt / split_cols; base += (size_t)t * split_stride; colt -= t * split_cols; if (t == 0) sc = scale0; }
        const int col0 = colt + wc * 32 + 8 * fq, bcol0 = u.pn * BM + wc * 32 + 8 * fq;
        f32x4 bv[2][2];
#pragma unroll
        for (int bj = 0; bj < 2; ++bj)
#pragma unroll
            for (int n = 0; n < 2; ++n) bv[bj][n] = bias ? *(const f32x4*)(bias + bcol0 + bj * HALF + 4 * n) : (f32x4){0.f, 0.f, 0.f, 0.f};
#pragma unroll
        for (int ai = 0; ai < 2; ++ai)
#pragma unroll
            for (int m = 0; m < 4; ++m) { bf16_t* rowp = base + (size_t)(row0 + ai * HALF + m * 16) * ldc + col0;
#pragma unroll
                for (int bj = 0; bj < 2; ++bj) { f32x4 v0 = acc[ai][bj][m][0] + bv[bj][0], v1 = acc[ai][bj][m][1] + bv[bj][1];
                    if (ACT == 1) { f32x2 a = gelu_pk((f32x2){v0[0], v0[1]}), b = gelu_pk((f32x2){v0[2], v0[3]}), c = gelu_pk((f32x2){v1[0], v1[1]}), d = gelu_pk((f32x2){v1[2], v1[3]});
                        v0 = (f32x4){a.x, a.y, b.x, b.y}; v1 = (f32x4){c.x, c.y, d.x, d.y}; }
                    v0 = v0 * sc; v1 = v1 * sc; u32x4 w; w.x = cvt_pk_bf16(v0[0], v0[1]); w.y = cvt_pk_bf16(v0[2], v0[3]); w.z = cvt_pk_bf16(v1[0], v1[1]); w.w = cvt_pk_bf16(v1[2], v1[3]);
                    *(u32x4*)(rowp + bj * HALF) = w; } }
    }
};

typedef float f32x2_t __attribute__((ext_vector_type(2))); typedef __bf16 bf16x2_t __attribute__((ext_vector_type(2)));
__device__ __forceinline__ unsigned pk2(float lo, float hi) { f32x2_t v = {lo, hi}; bf16x2_t b = __builtin_convertvector(v, bf16x2_t); return __builtin_bit_cast(unsigned, b); }
__device__ __forceinline__ float bflo(unsigned w) { return __uint_as_float(w << 16); }
__device__ __forceinline__ float bfhi(unsigned w) { return __uint_as_float(w & 0xffff0000u); }
__device__ __forceinline__ float gelu_tanh(float x) { const float t = x * (1.0f + 0.044715f * x * x); return x * __builtin_amdgcn_rcpf(1.0f + __builtin_amdgcn_exp2f(-2.3022082f * t)); }
__device__ __forceinline__ float sigmoid_f(float x) { return __builtin_amdgcn_rcpf(1.0f + __builtin_amdgcn_exp2f(-1.4426950409f * x)); }
__device__ __forceinline__ float logsigmoid_f(float x) { return fminf(x, 0.f) - log1pf(__expf(-fabsf(x))); }
constexpr int ZP = 3328;
struct EpiZ {
    static constexpr bool PERM = true, AFTER_DRAIN = false;
    bf16_t* Z; const float* rinv; float* LF; const float* bfv;
    __device__ __forceinline__ void operator()(const f32x4 (&acc)[2][2][4][2], const Unit& u, int wr, int wc, int fr, int fq) const {
        const int row0 = u.pm * BM + wr * 64 + fr, colb = u.pn * BM + wc * 32 + 8 * fq; const bool dog = u.pn < 2; const bool dof = (u.pn == 12) && (wc == 0) && (fq == 0);
#pragma unroll
        for (int ai = 0; ai < 2; ++ai)
#pragma unroll
            for (int m = 0; m < 4; ++m) { const int row = row0 + ai * HALF + m * 16; const float sc = rinv[row]; bf16_t* rowp = Z + (size_t)row * ZP + colb;
#pragma unroll
                for (int bj = 0; bj < 2; ++bj) { f32x4 v0 = acc[ai][bj][m][0] * sc, v1 = acc[ai][bj][m][1] * sc;
                    if (dog) { v0[0] = gelu_tanh(v0[0]); v0[1] = gelu_tanh(v0[1]); v0[2] = gelu_tanh(v0[2]); v0[3] = gelu_tanh(v0[3]); v1[0] = gelu_tanh(v1[0]); v1[1] = gelu_tanh(v1[1]); v1[2] = gelu_tanh(v1[2]); v1[3] = gelu_tanh(v1[3]); }
                    u32x4 w; w.x = pk2(v0[0], v0[1]); w.y = pk2(v0[2], v0[3]); w.z = pk2(v1[0], v1[1]); w.w = pk2(v1[2], v1[3]);
                    *(u32x4*)(rowp + bj * HALF) = w;
                    if (bj == 1 && dof) { float* lf = LF + (size_t)row * 8;
                        lf[0] = logsigmoid_f(v0[0] + bfv[0]); lf[1] = logsigmoid_f(v0[1] + bfv[1]); lf[2] = logsigmoid_f(v0[2] + bfv[2]); lf[3] = logsigmoid_f(v0[3] + bfv[3]);
                        lf[4] = logsigmoid_f(v1[0] + bfv[4]); lf[5] = logsigmoid_f(v1[1] + bfv[5]); } } }
    }
};
struct EpiY {
    static constexpr bool PERM = true, AFTER_DRAIN = false;
    bf16_t* Y; float* ssq; int ldc;
    __device__ __forceinline__ void operator()(const f32x4 (&acc)[2][2][4][2], const Unit& u, int wr, int wc, int fr, int fq) const {
        const int row0 = u.pm * BM + wr * 64 + fr, colb = u.pn * BM + wc * 32 + 8 * fq;
#pragma unroll
        for (int ai = 0; ai < 2; ++ai)
#pragma unroll
            for (int m = 0; m < 4; ++m) { const int row = row0 + ai * HALF + m * 16; bf16_t* rowp = Y + (size_t)row * ldc + colb; float ss = 0.f;
#pragma unroll
                for (int bj = 0; bj < 2; ++bj) { const f32x4 v0 = acc[ai][bj][m][0], v1 = acc[ai][bj][m][1];
                    ss += (v0[0] * v0[0] + v0[1] * v0[1]) + (v0[2] * v0[2] + v0[3] * v0[3]) + (v1[0] * v1[0] + v1[1] * v1[1]) + (v1[2] * v1[2] + v1[3] * v1[3]);
                    u32x4 w; w.x = pk2(v0[0], v0[1]); w.y = pk2(v0[2], v0[3]); w.z = pk2(v1[0], v1[1]); w.w = pk2(v1[2], v1[3]);
                    *(u32x4*)(rowp + bj * HALF) = w; }
                ss += __shfl_xor(ss, 16); ss += __shfl_xor(ss, 32);
                if (fq == 0) ssq[(size_t)row * 16 + (u.pn & 3) * 4 + wc] = ss; }
    }
};
struct EpiS {
    static constexpr bool PERM = true, AFTER_DRAIN = false;
    bf16_t* O; const float* rinv; int ldc;
    __device__ __forceinline__ void operator()(const f32x4 (&acc)[2][2][4][2], const Unit& u, int wr, int wc, int fr, int fq) const {
        const int row0 = u.pm * BM + wr * 64 + fr, colb = u.pn * BM + wc * 32 + 8 * fq;
#pragma unroll
        for (int ai = 0; ai < 2; ++ai)
#pragma unroll
            for (int m = 0; m < 4; ++m) { const int row = row0 + ai * HALF + m * 16; const float sc = rinv ? rinv[row] : 1.0f; bf16_t* rowp = O + (size_t)row * ldc + colb;
#pragma unroll
                for (int bj = 0; bj < 2; ++bj) { const f32x4 v0 = acc[ai][bj][m][0] * sc, v1 = acc[ai][bj][m][1] * sc;
                    u32x4 w; w.x = pk2(v0[0], v0[1]); w.y = pk2(v0[2], v0[3]); w.z = pk2(v1[0], v1[1]); w.w = pk2(v1[2], v1[3]);
                    *(u32x4*)(rowp + bj * HALF) = w; } }
    }
};
struct EpiAct {
    static constexpr bool PERM = true, AFTER_DRAIN = false;
    bf16_t* ACT; const bf16_t* G; const float* rinv; const float* cw; const float* cb;
    __device__ __forceinline__ void operator()(const f32x4 (&acc)[2][2][4][2], const Unit& u, int wr, int wc, int fr, int fq) const {
        const int row0 = u.pm * BM + wr * 64 + fr, colb = u.pn * BM + wc * 32 + 8 * fq;
#pragma unroll
        for (int bj = 0; bj < 2; ++bj) { const int col = colb + bj * HALF;
            float w0[8], w1[8], w2[8], b0[8];
#pragma unroll
            for (int j = 0; j < 2; ++j) { const f32x4 a = *(const f32x4*)(cw + col + 4 * j), b = *(const f32x4*)(cw + 4096 + col + 4 * j), c = *(const f32x4*)(cw + 8192 + col + 4 * j), d = *(const f32x4*)(cb + col + 4 * j);
#pragma unroll
                for (int k = 0; k < 4; ++k) { w0[4 * j + k] = a[k]; w1[4 * j + k] = b[k]; w2[4 * j + k] = c[k]; b0[4 * j + k] = d[k]; } }
#pragma unroll
            for (int ai = 0; ai < 2; ++ai)
#pragma unroll
                for (int m = 0; m < 4; ++m) { const int row = row0 + ai * HALF + m * 16; const float sc = rinv[row];
                    const bf16_t* gp = G + (size_t)row * 4096 + col; const u32x4 z4 = {0u, 0u, 0u, 0u};
                    const u32x4 g2 = *(const u32x4*)gp; const u32x4 g1 = row >= 1 ? *(const u32x4*)(gp - 4096) : z4; const u32x4 g0 = row >= 2 ? *(const u32x4*)(gp - 8192) : z4;
                    float o[8];
#pragma unroll
                    for (int k = 0; k < 4; ++k) { const unsigned a = g0[k], b = g1[k], c = g2[k];
                        const float c0 = b0[2 * k] + w0[2 * k] * bflo(a) + w1[2 * k] * bflo(b) + w2[2 * k] * bflo(c);
                        const float c1 = b0[2 * k + 1] + w0[2 * k + 1] * bfhi(a) + w1[2 * k + 1] * bfhi(b) + w2[2 * k + 1] * bfhi(c);
                        const float u0 = (k < 2 ? acc[ai][bj][m][0][2 * k] : acc[ai][bj][m][1][2 * k - 4]) * sc, u1 = (k < 2 ? acc[ai][bj][m][0][2 * k + 1] : acc[ai][bj][m][1][2 * k - 3]) * sc;
                        o[2 * k] = gelu_tanh(c0) * u0; o[2 * k + 1] = gelu_tanh(c1) * u1; }
                    u32x4 w; w.x = pk2(o[0], o[1]); w.y = pk2(o[2], o[3]); w.z = pk2(o[4], o[5]); w.w = pk2(o[6], o[7]);
                    *(u32x4*)(ACT + (size_t)row * 4096 + col) = w; } }
    }
};
struct EpiPle {
    static constexpr bool PERM = true, AFTER_DRAIN = false;
    bf16_t* Y; const bf16_t* E; const float* rinv; float* ssq;
    __device__ __forceinline__ void operator()(const f32x4 (&acc)[2][2][4][2], const Unit& u, int wr, int wc, int fr, int fq) const {
        const int row0 = u.pm * BM + wr * 64 + fr, colb = u.pn * BM + wc * 32 + 8 * fq;
#pragma unroll
        for (int ai = 0; ai < 2; ++ai)
#pragma unroll
            for (int m = 0; m < 4; ++m) { const int row = row0 + ai * HALF + m * 16; const float sc = rinv[row]; float ss = 0.f;
#pragma unroll
                for (int bj = 0; bj < 2; ++bj) { const size_t off = (size_t)row * 1024 + colb + bj * HALF; const u32x4 e = *(const u32x4*)(E + off);
                    const f32x4 v0 = acc[ai][bj][m][0] * sc, v1 = acc[ai][bj][m][1] * sc; float o[8];
                    o[0] = bflo(e.x) * sigmoid_f(v0[0]); o[1] = bfhi(e.x) * sigmoid_f(v0[1]); o[2] = bflo(e.y) * sigmoid_f(v0[2]); o[3] = bfhi(e.y) * sigmoid_f(v0[3]);
                    o[4] = bflo(e.z) * sigmoid_f(v1[0]); o[5] = bfhi(e.z) * sigmoid_f(v1[1]); o[6] = bflo(e.w) * sigmoid_f(v1[2]); o[7] = bfhi(e.w) * sigmoid_f(v1[3]);
#pragma unroll
                    for (int k = 0; k < 8; ++k) ss += o[k] * o[k];
                    u32x4 w; w.x = pk2(o[0], o[1]); w.y = pk2(o[2], o[3]); w.z = pk2(o[4], o[5]); w.w = pk2(o[6], o[7]);
                    *(u32x4*)(Y + off) = w; }
                ss += __shfl_xor(ss, 16); ss += __shfl_xor(ss, 32);
                if (fq == 0) ssq[(size_t)row * 16 + (u.pn & 3) * 4 + wc] = ss; }
    }
};
template <class Epi, class Sched, bool ALIGN_EPI = false, bool SP2 = false>
__device__ __forceinline__ void gemm_phase(PG8_LAS unsigned char* lds, const Gemm g, const Sched& S, const Epi& E) {
    int tid_o = threadIdx.x; asm volatile("" : "+v"(tid_o));
    const int tid = tid_o, wid = __builtin_amdgcn_readfirstlane(tid >> 6), lane = tid & 63, wr = wid >> 2, wc = wid & 3, fr = lane & 15, fq = lane >> 4;
    const int K = g.K, nt = K / BK;
    unsigned voffA[2], voffB[2];
#pragma unroll
    for (int i = 0; i < 2; ++i) { int R, C; stage_rc(tid * 16 + i * 8192, R, C); const int Rb = Epi::PERM ? ((R & ~31) + perm32(R & 31)) : R;
        voffA[i] = (unsigned)(R * K + C) * 2u; voffB[i] = (unsigned)(Rb * K + C) * 2u; }
    const size_t kstep = (size_t)(BK * 2);
    const size_t hstep = (size_t)HALF * K * 2;
    const size_t tstep = 2 * hstep;
    const unsigned ldsw = (unsigned)wid * 1024u;
    const int aoff = lds_byte(wr * 64 + fr, fq * 8), boff = lds_byte(wc * 32 + fr, fq * 8);
#define PG8_SA(b, h) (((b) * 2 + (h)) * HTB)
#define PG8_SB(b, h) ((4 + (b) * 2 + (h)) * HTB)
#define PG8_STAGE(bufoff, gbase, voff) do { _Pragma("unroll") for (int _i = 0; _i < 2; ++_i) \
        __builtin_amdgcn_global_load_lds((const unsigned*)((const char*)(gbase) + (voff)[_i]), (PG8_LAS unsigned*)(lds + (bufoff) + ldsw + _i * 8192), 16, 0, 0); } while (0)
#define PG8_LDA(dst, b, h) do { _Pragma("unroll") for (int m = 0; m < 4; ++m) _Pragma("unroll") for (int k = 0; k < 2; ++k) dst[m][k] = *(const PG8_LAS bf16x8*)(lds + PG8_SA(b, h) + aoff + m * 2048 + k * 1024); } while (0)
#define PG8_LDB(dst, b, h) do { _Pragma("unroll") for (int n = 0; n < 2; ++n) _Pragma("unroll") for (int k = 0; k < 2; ++k) dst[n][k] = *(const PG8_LAS bf16x8*)(lds + PG8_SB(b, h) + boff + n * 2048 + k * 1024); } while (0)
#define PG8_MMA(ai, bj, At, Bt) do { __builtin_amdgcn_s_setprio(1); _Pragma("unroll") for (int m = 0; m < 4; ++m) _Pragma("unroll") for (int n = 0; n < 2; ++n) _Pragma("unroll") for (int k = 0; k < 2; ++k) \
        acc[ai][bj][m][n] = __builtin_amdgcn_mfma_f32_16x16x32_bf16(Bt[n][k], At[m][k], acc[ai][bj][m][n], 0, 0, 0); __builtin_amdgcn_s_setprio(0); } while (0)
#define PG8_WAIT_V(n) asm volatile("s_waitcnt vmcnt(" #n ")" ::: "memory")
#define PG8_WAIT_L(n) asm volatile("s_waitcnt lgkmcnt(" #n ")" ::: "memory")
#define PG8_BAR __builtin_amdgcn_s_barrier()
#define PG8_SCHED __builtin_amdgcn_sched_barrier(0)
    Unit cur, nxt; int ui = 0;
    if (!S.next(0, cur)) return;
    f32x4 acc[2][2][4][2];
#pragma unroll
    for (int a = 0; a < 2; ++a)
#pragma unroll
        for (int b = 0; b < 2; ++b)
#pragma unroll
            for (int m = 0; m < 4; ++m)
#pragma unroll
                for (int n = 0; n < 2; ++n) acc[a][b][m][n] = (f32x4){0.f, 0.f, 0.f, 0.f};
    bf16x8 At[4][2], B0[2][2], B1[2][2];
    const char* cA = (const char*)g.A + (size_t)cur.pm * tstep; const char* cB = (const char*)g.Bt + (size_t)cur.pn * tstep;
    S.a_ready(cur);
    if constexpr (SP2) {
        PG8_STAGE(PG8_SB(0, 0), cB, voffB); PG8_STAGE(PG8_SB(0, 1), cB + hstep, voffB); PG8_STAGE(PG8_SA(0, 0), cA, voffA); PG8_STAGE(PG8_SA(0, 1), cA + hstep, voffA);
        if (wr == 1) PG8_BAR;
        PG8_WAIT_V(2); PG8_BAR;
        PG8_STAGE(PG8_SB(1, 0), cB + kstep, voffB); PG8_STAGE(PG8_SA(1, 0), cA + kstep, voffA); PG8_STAGE(PG8_SB(1, 1), cB + hstep + kstep, voffB);
        PG8_WAIT_V(6); PG8_BAR;
    } else {
        PG8_STAGE(PG8_SB(0, 0), cB, voffB); PG8_STAGE(PG8_SA(0, 0), cA, voffA); PG8_STAGE(PG8_SB(0, 1), cB + hstep, voffB); PG8_STAGE(PG8_SA(0, 1), cA + hstep, voffA);
        if (wr == 1) PG8_BAR;
        PG8_WAIT_V(4); PG8_BAR;
        PG8_STAGE(PG8_SB(1, 0), cB + kstep, voffB); PG8_STAGE(PG8_SA(1, 0), cA + kstep, voffA); PG8_STAGE(PG8_SB(1, 1), cB + hstep + kstep, voffB);
        PG8_WAIT_V(6); PG8_BAR;
    }
    for (;;) {
        const bool has_next = S.next(ui + 1, nxt);
        const char* nA = has_next ? (const char*)g.A + (size_t)nxt.pm * tstep : cA; const char* nB = has_next ? (const char*)g.Bt + (size_t)nxt.pn * tstep : cB;
        for (int t = 0; t < nt; t += 2) {
            const bool last = (t == nt - 2);
            const char* a1 = cA + (size_t)(t + 1) * kstep;
            const char* a2 = last ? nA : cA + (size_t)(t + 2) * kstep; const char* b2 = last ? nB : cB + (size_t)(t + 2) * kstep;
            const char* a3 = a2 + kstep; const char* b3 = b2 + kstep;
            if (last && has_next) S.a_ready(nxt);
            if constexpr (SP2) {
            PG8_LDB(B0, 0, 0); PG8_LDB(B1, 0, 1); PG8_SCHED; PG8_LDA(At, 0, 0); PG8_STAGE(PG8_SA(1, 1), a1 + hstep, voffA);
            PG8_WAIT_V(8); PG8_WAIT_L(0); PG8_BAR; PG8_MMA(0, 0, At, B0); PG8_MMA(0, 1, At, B1); PG8_BAR; PG8_SCHED;
            PG8_LDA(At, 0, 1); PG8_STAGE(PG8_SB(0, 0), b2, voffB); PG8_STAGE(PG8_SB(0, 1), b2 + hstep, voffB); PG8_STAGE(PG8_SA(0, 0), a2, voffA);
            PG8_WAIT_V(8); PG8_WAIT_L(0); PG8_BAR; PG8_MMA(1, 0, At, B0); PG8_MMA(1, 1, At, B1); PG8_BAR; PG8_SCHED;
            PG8_LDB(B0, 1, 0); PG8_LDB(B1, 1, 1); PG8_SCHED; PG8_LDA(At, 1, 0); PG8_STAGE(PG8_SA(0, 1), a2 + hstep, voffA);
            PG8_WAIT_V(8); PG8_WAIT_L(0); PG8_BAR; PG8_MMA(0, 0, At, B0); PG8_MMA(0, 1, At, B1); PG8_BAR; PG8_SCHED;
            PG8_LDA(At, 1, 1); PG8_STAGE(PG8_SB(1, 0), b3, voffB); PG8_STAGE(PG8_SB(1, 1), b3 + hstep, voffB); PG8_STAGE(PG8_SA(1, 0), a3, voffA);
            PG8_WAIT_V(8); PG8_WAIT_L(0); PG8_BAR; PG8_MMA(1, 0, At, B0); PG8_MMA(1, 1, At, B1); PG8_BAR; PG8_SCHED;
            } else {
            PG8_LDB(B0, 0, 0); PG8_SCHED; PG8_LDA(At, 0, 0); PG8_STAGE(PG8_SA(1, 1), a1 + hstep, voffA);
            PG8_WAIT_L(8); PG8_BAR; PG8_WAIT_L(0); PG8_MMA(0, 0, At, B0); PG8_BAR; PG8_SCHED;
            PG8_LDB(B1, 0, 1); PG8_STAGE(PG8_SB(0, 0), b2, voffB);
            PG8_BAR; PG8_WAIT_L(0); PG8_MMA(0, 1, At, B1); PG8_BAR;
            PG8_LDA(At, 0, 1); PG8_STAGE(PG8_SA(0, 0), a2, voffA);
            PG8_BAR; PG8_WAIT_L(0); PG8_MMA(1, 0, At, B0); PG8_BAR; PG8_SCHED;
            PG8_STAGE(PG8_SB(0, 1), b2 + hstep, voffB);
            PG8_WAIT_V(6); PG8_BAR; PG8_MMA(1, 1, At, B1); PG8_BAR;
            PG8_LDB(B0, 1, 0); PG8_SCHED; PG8_LDA(At, 1, 0); PG8_STAGE(PG8_SA(0, 1), a2 + hstep, voffA);
            PG8_WAIT_L(8); PG8_BAR; PG8_WAIT_L(0); PG8_MMA(0, 0, At, B0); PG8_BAR; PG8_SCHED;
            PG8_LDB(B1, 1, 1); PG8_STAGE(PG8_SB(1, 0), b3, voffB);
            PG8_BAR; PG8_WAIT_L(0); PG8_MMA(0, 1, At, B1); PG8_BAR;
            PG8_LDA(At, 1, 1); PG8_STAGE(PG8_SA(1, 0), a3, voffA);
            PG8_BAR; PG8_WAIT_L(0); PG8_MMA(1, 0, At, B0); PG8_BAR; PG8_SCHED;
            PG8_STAGE(PG8_SB(1, 1), b3 + hstep, voffB);
            PG8_WAIT_V(6); PG8_BAR; PG8_MMA(1, 1, At, B1); PG8_BAR;
            }
        }
        if constexpr (ALIGN_EPI) { if (wr == 0) PG8_BAR; }
        if constexpr (!Epi::AFTER_DRAIN) { E(acc, cur, wr, wc, fr, fq); S.done(cur); }
        if (!has_next) break;
#pragma unroll
        for (int a = 0; a < 2; ++a)
#pragma unroll
            for (int b = 0; b < 2; ++b)
#pragma unroll
                for (int m = 0; m < 4; ++m)
#pragma unroll
                    for (int n = 0; n < 2; ++n) acc[a][b][m][n] = (f32x4){0.f, 0.f, 0.f, 0.f};
        cur = nxt; cA = nA; cB = nB; ++ui;
        if constexpr (ALIGN_EPI) { if (wr == 1) PG8_BAR; }
    }
    PG8_WAIT_V(0);
    if constexpr (!ALIGN_EPI) { if (wr == 0) PG8_BAR; }
    PG8_BAR;
    if constexpr (Epi::AFTER_DRAIN) { E.fused(acc, cur, wr, wc, fr, fq, lds, wid, lane); S.done(cur); }
#undef PG8_SA
#undef PG8_SB
#undef PG8_STAGE
#undef PG8_LDA
#undef PG8_LDB
#undef PG8_MMA
#undef PG8_WAIT_V
#undef PG8_WAIT_L
#undef PG8_BAR
#undef PG8_SCHED
}
}
#define DI __device__ __forceinline__
typedef unsigned short bf16;
typedef short bf16x8 __attribute__((ext_vector_type(8)));
typedef float f32x4 __attribute__((ext_vector_type(4)));
typedef float f32x16 __attribute__((ext_vector_type(16)));
typedef unsigned u32x4 __attribute__((ext_vector_type(4)));
typedef unsigned u32x2 __attribute__((ext_vector_type(2)));
using pg8::pk2; using pg8::bflo; using pg8::bfhi; using pg8::ZP;
#define MFMA32(a, b, c) __builtin_amdgcn_mfma_f32_32x32x16_bf16((a), (b), (c), 0, 0, 0)
constexpr int NB = 2, S = 16384, T = NB * S, DM = 1024, DEPTH = 2, DFF = 4096, NIN = 3206;
constexpr float EPS = 1e-6f, LOG2E = 1.4426950408889634f;
constexpr int NCH = S / 128;
enum { I_X = 0, I_P, I_POS, I_MIXPRE, I_WIN, I_SGUVG, I_SGUW, I_SGUB, I_FOXB, I_WO, I_MIXPOST, I_FFNPRE, I_WGATE, I_WUP, I_CONVW, I_CONVB, I_WDOWN, I_FFNPOST, I_PLEPRE, I_WPG, I_WPP, I_PLEPOST, N_INPUTS };
constexpr size_t MiB = 1u << 20;
constexpr size_t WS_CTL = 0;
constexpr size_t WS_RINVX = 1 * MiB;
constexpr size_t WS_SSQY = WS_RINVX + 128 * 1024;
constexpr size_t WS_CT = WS_SSQY + 128 * 1024;
constexpr size_t WS_KN = WS_CT + 8 * 1024;
constexpr size_t WS_KPMS = WS_CT + 16 * 1024;
constexpr size_t WS_LF = 2 * MiB;
constexpr size_t WS_CL = 3 * MiB;
constexpr size_t WS_C2 = 4 * MiB;
constexpr size_t WS_COS = 5 * MiB;
constexpr size_t WS_SIN = 9 * MiB;
constexpr size_t WS_SSQP = 13 * MiB;
constexpr size_t WS_W = 16 * MiB;
constexpr size_t W_IN = 0, W_O = W_IN + (size_t)ZP * 1024 * 2, W_G = W_O + 2 * MiB, W_U = W_G + 8 * MiB, W_D = W_U + 8 * MiB, W_PG = W_D + 8 * MiB, W_PP = W_PG + 2 * MiB;
constexpr size_t WS_PB = 52 * MiB;
constexpr size_t WS_XB = 68 * MiB;
constexpr size_t WS_RB = 132 * MiB;
constexpr size_t WS_RA = 232 * MiB;
constexpr size_t WS_END = 488 * MiB;
static_assert(W_PP + 512 * 1024 <= 36 * MiB, "weights");

struct Params { const float* in[N_INPUTS]; float* out; unsigned char* ws; float lg2gam[6]; int pad[2]; };

DI float wave_sum(float v) {
#pragma unroll
    for (int o = 1; o < 64; o <<= 1) v += __shfl_xor(v, o);
    return v;
}
DI int crow(int reg, int h) { return (reg & 3) + 8 * (reg >> 2) + 4 * h; }
DI unsigned short f2bf(float f) { return (unsigned short)(pk2(f, 0.f) & 0xffffu); }
DI float bf2f(unsigned short h) { return __uint_as_float((unsigned)h << 16); }
DI bf16x8 pack8(const f32x16& x, int s8) { u32x4 p; p.x = pk2(x[s8], x[s8 + 1]); p.y = pk2(x[s8 + 2], x[s8 + 3]); p.z = pk2(x[s8 + 4], x[s8 + 5]); p.w = pk2(x[s8 + 6], x[s8 + 7]); return __builtin_bit_cast(bf16x8, p); }

DI void transpose_item(const float* W, const float* g, int K, int N, int nblk, bf16* WT, float* scr, int item, int lane) {
    const int kb = item / nblk, nb = item % nblk, k0 = 64 * kb, n0 = 32 * nb;
    const int n = n0 + (lane & 31); const bool ok = n < N;
#pragma unroll 8
    for (int i = 0; i < 32; ++i) { const int kk = 2 * i + (lane >> 5); float v = ok ? W[(size_t)(k0 + kk) * N + n] : 0.f; if (g) v *= g[k0 + kk]; scr[kk * 33 + (lane & 31)] = v; }
    asm volatile("s_waitcnt lgkmcnt(0)" ::: "memory");
    const int c = lane & 7;
#pragma unroll
    for (int j = 0; j < 4; ++j) { const int nn = (lane >> 3) + 8 * j; const float* s = scr + (8 * c) * 33 + nn;
        u32x4 o; o.x = pk2(s[0 * 33], s[1 * 33]); o.y = pk2(s[2 * 33], s[3 * 33]); o.z = pk2(s[4 * 33], s[5 * 33]); o.w = pk2(s[6 * 33], s[7 * 33]);
        *(u32x4*)(WT + (size_t)(n0 + nn) * K + k0 + 8 * c) = o; }
    asm volatile("s_waitcnt lgkmcnt(0)" ::: "memory");
}
DI void convert_weights(const Params& P, int layer, char* lds, int gw, int NGW, int wave, int lane) {
    float* scr = (float*)(lds + wave * 16384);
    unsigned char* wb = P.ws + WS_W;
    constexpr int I_IN = 16 * 104, I_O = 16 * 32, I_G = 16 * 128, I_D = 64 * 32, I_PG = 16 * 32, I_PP = 4 * 32;
    constexpr int NITEMS = I_IN + I_O + 2 * I_G + I_D + I_PG + I_PP;
    for (int it = gw; it < NITEMS; it += NGW) {
        int r = it;
        if (r < I_IN) { transpose_item(P.in[I_WIN] + (size_t)layer * 1024 * NIN, P.in[I_MIXPRE] + layer * 1024, 1024, NIN, 104, (bf16*)(wb + W_IN), scr, r, lane); continue; } r -= I_IN;
        if (r < I_O) { transpose_item(P.in[I_WO] + (size_t)layer * 1024 * 1024, nullptr, 1024, 1024, 32, (bf16*)(wb + W_O), scr, r, lane); continue; } r -= I_O;
        if (r < I_G) { transpose_item(P.in[I_WGATE] + (size_t)layer * 1024 * DFF, P.in[I_FFNPRE] + layer * 1024, 1024, DFF, 128, (bf16*)(wb + W_G), scr, r, lane); continue; } r -= I_G;
        if (r < I_G) { transpose_item(P.in[I_WUP] + (size_t)layer * 1024 * DFF, P.in[I_FFNPRE] + layer * 1024, 1024, DFF, 128, (bf16*)(wb + W_U), scr, r, lane); continue; } r -= I_G;
        if (r < I_D) { transpose_item(P.in[I_WDOWN] + (size_t)layer * DFF * 1024, nullptr, DFF, 1024, 32, (bf16*)(wb + W_D), scr, r, lane); continue; } r -= I_D;
        if (r < I_PG) { transpose_item(P.in[I_WPG] + (size_t)layer * 1024 * 1024, P.in[I_PLEPRE] + layer * 1024, 1024, 1024, 32, (bf16*)(wb + W_PG), scr, r, lane); continue; } r -= I_PG;
        transpose_item(P.in[I_WPP] + (size_t)layer * 256 * 1024, nullptr, 256, 1024, 32, (bf16*)(wb + W_PP), scr, r, lane);
    }
    const float* pp = P.in[I_P] + (size_t)layer * T * 256; bf16* pb = (bf16*)(P.ws + WS_PB);
    for (size_t i = (size_t)gw * 64 + lane; i < (size_t)T * 256 / 8; i += (size_t)NGW * 64) {
        const f32x4 a = *(const f32x4*)(pp + i * 8), b = *(const f32x4*)(pp + i * 8 + 4);
        u32x4 o; o.x = pk2(a[0], a[1]); o.y = pk2(a[2], a[3]); o.z = pk2(b[0], b[1]); o.w = pk2(b[2], b[3]);
        *(u32x4*)(pb + i * 8) = o; }
}
DI void resid_rows(const Params& P, const float* xsrc, float* xdst, const bf16* Y, const float* gain, int gw, int NGW, int lane) {
    const float* ssqp = (const float*)(P.ws + WS_SSQP); float* rinvx = (float*)(P.ws + WS_RINVX); bf16* XB = (bf16*)(P.ws + WS_XB);
    for (int row = gw; row < T; row += NGW) {
        const size_t off = (size_t)row * 1024 + lane * 8;
        float v[16];
        if (xsrc) {
#pragma unroll
        for (int j = 0; j < 2; ++j) { const f32x4 a = *(const f32x4*)(xsrc + off + j * 512), b = *(const f32x4*)(xsrc + off + j * 512 + 4);
            v[8 * j + 0] = a[0]; v[8 * j + 1] = a[1]; v[8 * j + 2] = a[2]; v[8 * j + 3] = a[3]; v[8 * j + 4] = b[0]; v[8 * j + 5] = b[1]; v[8 * j + 6] = b[2]; v[8 * j + 7] = b[3]; }
        } else {
#pragma unroll
        for (int j = 0; j < 2; ++j) { const u32x4 a = *(const u32x4*)(XB + off + j * 512);
            v[8 * j + 0] = bflo(a.x); v[8 * j + 1] = bfhi(a.x); v[8 * j + 2] = bflo(a.y); v[8 * j + 3] = bfhi(a.y); v[8 * j + 4] = bflo(a.z); v[8 * j + 5] = bfhi(a.z); v[8 * j + 6] = bflo(a.w); v[8 * j + 7] = bfhi(a.w); }
        }
        if (Y) { float sp = lane < 16 ? ssqp[(size_t)row * 16 + lane] : 0.f; sp = wave_sum(sp); const float ry = rsqrtf(sp * (1.0f / 1024.0f) + EPS);
#pragma unroll
            for (int j = 0; j < 2; ++j) { const u32x4 y = *(const u32x4*)(Y + off + j * 512); const f32x4 g0 = *(const f32x4*)(gain + lane * 8 + j * 512), g1 = *(const f32x4*)(gain + lane * 8 + j * 512 + 4);
                v[8 * j + 0] += bflo(y.x) * ry * g0[0]; v[8 * j + 1] += bfhi(y.x) * ry * g0[1]; v[8 * j + 2] += bflo(y.y) * ry * g0[2]; v[8 * j + 3] += bfhi(y.y) * ry * g0[3];
                v[8 * j + 4] += bflo(y.z) * ry * g1[0]; v[8 * j + 5] += bfhi(y.z) * ry * g1[1]; v[8 * j + 6] += bflo(y.w) * ry * g1[2]; v[8 * j + 7] += bfhi(y.w) * ry * g1[3]; }
        }
        float ss = 0.f;
#pragma unroll
        for (int k = 0; k < 16; ++k) ss += v[k] * v[k];
        ss = wave_sum(ss);
#pragma unroll
        for (int j = 0; j < 2; ++j) {
            if (xdst) { *(f32x4*)(xdst + off + j * 512) = (f32x4){v[8 * j], v[8 * j + 1], v[8 * j + 2], v[8 * j + 3]}; *(f32x4*)(xdst + off + j * 512 + 4) = (f32x4){v[8 * j + 4], v[8 * j + 5], v[8 * j + 6], v[8 * j + 7]}; }
            u32x4 o; o.x = pk2(v[8 * j], v[8 * j + 1]); o.y = pk2(v[8 * j + 2], v[8 * j + 3]); o.z = pk2(v[8 * j + 4], v[8 * j + 5]); o.w = pk2(v[8 * j + 6], v[8 * j + 7]);
            *(u32x4*)(XB + off + j * 512) = o; }
        if (lane == 0) rinvx[row] = rsqrtf(ss * (1.0f / 1024.0f) + EPS);
    }
}
DI void rope_table(const Params& P, int gtid, int NT) {
    const int* pos = (const int*)P.in[I_POS]; float* C = (float*)(P.ws + WS_COS); float* Sn = (float*)(P.ws + WS_SIN);
    for (int i = gtid; i < T * 32; i += NT) { const int row = i >> 5, j = i & 31;
        const double invf = exp2(-(double)j * (13.287712379549449 / 32.0));
        const double ang = (double)pos[row] * invf;
        const double q = rint(ang * 0.6366197723675814); const double y = fma(-q, 1.5707963267948966, ang) - q * 6.123233995736766e-17;
        const double y2 = y * y;
        const double sp = y * (1.0 + y2 * (-1.0 / 6 + y2 * (1.0 / 120 + y2 * (-1.0 / 5040 + y2 * (1.0 / 362880 + y2 * (-1.0 / 39916800))))));
        const double cp = 1.0 + y2 * (-0.5 + y2 * (1.0 / 24 + y2 * (-1.0 / 720 + y2 * (1.0 / 40320 + y2 * (-1.0 / 3628800 + y2 * (1.0 / 479001600))))));
        const int qi = (int)((long long)q & 3);
        const double sv = (qi == 0) ? sp : (qi == 1) ? cp : (qi == 2) ? -sp : -cp;
        const double cv = (qi == 0) ? cp : (qi == 1) ? -sp : (qi == 2) ? -cp : sp;
        C[i] = (float)cv; Sn[i] = (float)sv; }
}
constexpr int ST72 = 72, ST136 = 136, ST68 = 68;
DI void sgu_unit(const Params& P, int layer, int b, int c, int hh, char* lds) {
    int tid_u = threadIdx.x; asm volatile("" : "+v"(tid_u)); const int tid = tid_u, lane = tid & 63, wid = tid >> 6, r = lane & 31, h = lane >> 5;
    bf16* Wt = (bf16*)lds; bf16* VT = Wt + 128 * ST136;
    const bf16* Z = (const bf16*)(P.ws + WS_RA); bf16* MIX = (bf16*)(P.ws + WS_RB);
    const float* W = P.in[I_SGUW] + (size_t)(layer * 4 + hh) * 128 * 128;
#pragma unroll
    for (int j = 0; j < 8; ++j) { const int idx = (j * 512 + tid) * 4, t = idx >> 7, s = idx & 127; const f32x4 w = *(const f32x4*)(W + idx);
        u32x2 o; o.x = pk2(s <= t ? w[0] : 0.f, s + 1 <= t ? w[1] : 0.f); o.y = pk2(s + 2 <= t ? w[2] : 0.f, s + 3 <= t ? w[3] : 0.f);
        *(u32x2*)(Wt + t * ST136 + s) = o; }
    const size_t row0 = (size_t)b * S + (size_t)c * 128;
    { const int s = tid >> 2, dq = tid & 3; const bf16* vp = Z + (row0 + s) * ZP + 256 + hh * 64 + dq * 16;
      const u32x4 a = *(const u32x4*)vp, bb = *(const u32x4*)(vp + 8); float v[16];
      v[0] = bflo(a.x); v[1] = bfhi(a.x); v[2] = bflo(a.y); v[3] = bfhi(a.y); v[4] = bflo(a.z); v[5] = bfhi(a.z); v[6] = bflo(a.w); v[7] = bfhi(a.w);
      v[8] = bflo(bb.x); v[9] = bfhi(bb.x); v[10] = bflo(bb.y); v[11] = bfhi(bb.y); v[12] = bflo(bb.z); v[13] = bfhi(bb.z); v[14] = bflo(bb.w); v[15] = bfhi(bb.w);
      float ss = 0.f;
#pragma unroll
      for (int i = 0; i < 16; ++i) ss += v[i] * v[i];
      ss += __shfl_xor(ss, 1); ss += __shfl_xor(ss, 2);
      const float rn = rsqrtf(ss * (1.0f / 64.0f) + EPS); const float* g = P.in[I_SGUVG] + (layer * 4 + hh) * 64 + dq * 16;
#pragma unroll
      for (int i = 0; i < 16; ++i) VT[(dq * 16 + i) * ST136 + s] = f2bf(v[i] * rn * g[i]); }
    __syncthreads();
    const int tb = wid >> 1, db = wid & 1; f32x16 acc = {};
    for (int ks = 0; ks < 2 * (tb + 1); ++ks) { const bf16x8 a = *(const bf16x8*)(Wt + (32 * tb + r) * ST136 + 16 * ks + 8 * h); const bf16x8 bb = *(const bf16x8*)(VT + (32 * db + r) * ST136 + 16 * ks + 8 * h); acc = MFMA32(a, bb, acc); }
    const float* bs = P.in[I_SGUB] + (layer * 4 + hh) * 128;
#pragma unroll
    for (int i = 0; i < 16; ++i) { const int t = 32 * tb + crow(i, h), d = 32 * db + r; const float uu = bf2f(Z[(row0 + t) * ZP + hh * 64 + d]);
        MIX[(row0 + t) * 1024 + hh * 64 + d] = f2bf(uu * (acc[i] + bs[t])); }
    __syncthreads();
}
DI void load_rot(const bf16* zh, const float* cs, const float* sn, int dq, float scale, float (&o1)[8], float (&o2)[8]) {
    const u32x4 a = *(const u32x4*)(zh + dq * 8), bb = *(const u32x4*)(zh + 32 + dq * 8);
    const f32x4 c0 = *(const f32x4*)(cs + dq * 8), c1 = *(const f32x4*)(cs + dq * 8 + 4), s0 = *(const f32x4*)(sn + dq * 8), s1 = *(const f32x4*)(sn + dq * 8 + 4);
    float x1[8] = {bflo(a.x), bfhi(a.x), bflo(a.y), bfhi(a.y), bflo(a.z), bfhi(a.z), bflo(a.w), bfhi(a.w)};
    float x2[8] = {bflo(bb.x), bfhi(bb.x), bflo(bb.y), bfhi(bb.y), bflo(bb.z), bfhi(bb.z), bflo(bb.w), bfhi(bb.w)};
#pragma unroll
    for (int j = 0; j < 8; ++j) { const float cc = j < 4 ? c0[j & 3] : c1[j & 3], sv = j < 4 ? s0[j & 3] : s1[j & 3];
        o1[j] = (x1[j] * cc - x2[j] * sv) * scale; o2[j] = (x1[j] * sv + x2[j] * cc) * scale; }
}
DI void ret1_unit(const Params& P, float lg, int b, int hh, int c, char* lds) {
    int tid_u = threadIdx.x; asm volatile("" : "+v"(tid_u)); const int tid = tid_u, lane = tid & 63, wid = tid >> 6, r = lane & 31, h = lane >> 5;
    bf16* KT = (bf16*)lds; bf16* VT = KT + 64 * ST136;
    const bf16* Z = (const bf16*)(P.ws + WS_RA); float* ST = (float*)(P.ws + WS_RB + 64 * MiB);
    const size_t row0 = (size_t)b * S + (size_t)c * 128;
    { const int s = tid >> 2, dq = tid & 3; const size_t row = row0 + s; float o1[8], o2[8];
      load_rot(Z + row * ZP + 896 + hh * 64, (const float*)(P.ws + WS_COS) + row * 32, (const float*)(P.ws + WS_SIN) + row * 32, dq, 0.125f * __builtin_amdgcn_exp2f((float)(127 - s) * lg), o1, o2);
#pragma unroll
      for (int j = 0; j < 8; ++j) { KT[(dq * 8 + j) * ST136 + s] = f2bf(o1[j]); KT[(32 + dq * 8 + j) * ST136 + s] = f2bf(o2[j]); }
      const bf16* vp = Z + row * ZP + 1280 + hh * 64 + dq * 16; const u32x4 a = *(const u32x4*)vp, bb = *(const u32x4*)(vp + 8);
      const unsigned vv[8] = {a.x, a.y, a.z, a.w, bb.x, bb.y, bb.z, bb.w};
#pragma unroll
      for (int i = 0; i < 8; ++i) { VT[(dq * 16 + 2 * i) * ST136 + s] = (bf16)(vv[i] & 0xffffu); VT[(dq * 16 + 2 * i + 1) * ST136 + s] = (bf16)(vv[i] >> 16); } }
    __syncthreads();
    if (wid < 4) { const int db = wid >> 1, eb = wid & 1; f32x16 acc = {};
#pragma unroll
        for (int ks = 0; ks < 8; ++ks) { const bf16x8 a = *(const bf16x8*)(KT + (32 * db + r) * ST136 + 16 * ks + 8 * h); const bf16x8 bb = *(const bf16x8*)(VT + (32 * eb + r) * ST136 + 16 * ks + 8 * h); acc = MFMA32(a, bb, acc); }
        float* st = ST + ((size_t)((b * 6 + hh) * NCH + c)) * 4096;
#pragma unroll
        for (int i = 0; i < 16; ++i) st[(32 * db + crow(i, h)) * 64 + 32 * eb + r] = acc[i]; }
    __syncthreads();
}
DI void cum_unit(const Params& P, int b, int c) {
    int tid_u = threadIdx.x; asm volatile("" : "+v"(tid_u)); const int tid = tid_u, lane = tid & 63, wid = tid >> 6;
    if (wid < 6) { const float* LF = (const float*)(P.ws + WS_LF); float* CL = (float*)(P.ws + WS_CL); float* CT = (float*)(P.ws + WS_CT);
        const size_t row = (size_t)b * S + (size_t)c * 128 + 2 * lane; const float v0 = LF[row * 8 + wid], v1 = LF[(row + 1) * 8 + wid];
        float x = v0 + v1;
#pragma unroll
        for (int o = 1; o < 64; o <<= 1) { const float y = __shfl_up(x, o); if (lane >= o) x += y; }
        float* cl = CL + (size_t)(b * 6 + wid) * S + (size_t)c * 128 + 2 * lane; cl[0] = x - v1; cl[1] = x;
        if (lane == 63) CT[(b * 6 + wid) * NCH + c] = x;
        const bf16* Z = (const bf16*)(P.ws + WS_RA); float km = 0.f;
#pragma unroll
        for (int rr = 0; rr < 2; ++rr) { const bf16* kp = Z + (row + rr) * ZP + 2432 + wid * 64; float ss = 0.f;
#pragma unroll
            for (int j = 0; j < 8; ++j) { const u32x4 w = *(const u32x4*)(kp + 8 * j);
                ss += bflo(w.x) * bflo(w.x) + bfhi(w.x) * bfhi(w.x) + bflo(w.y) * bflo(w.y) + bfhi(w.y) * bfhi(w.y) + bflo(w.z) * bflo(w.z) + bfhi(w.z) * bfhi(w.z) + bflo(w.w) * bflo(w.w) + bfhi(w.w) * bfhi(w.w); }
            km = fmaxf(km, ss); }
#pragma unroll
        for (int o = 1; o < 64; o <<= 1) km = fmaxf(km, __shfl_xor(km, o));
        if (lane == 0) ((float*)(P.ws + WS_KN))[(b * 6 + wid) * NCH + c] = km; }
}
DI void ret3_unit(const Params& P, float lg, int b, int hh, int c, char* lds) {
    int tid_u = threadIdx.x; asm volatile("" : "+v"(tid_u)); const int tid = tid_u, lane = tid & 63, wid = tid >> 6, r = lane & 31, h = lane >> 5;
    bf16* Q = (bf16*)lds; bf16* K = Q + 128 * ST72; bf16* VT = K + 128 * ST72; bf16* RT = VT + 64 * ST136; bf16* Pm = RT + 64 * ST72; float* O = (float*)lds;
    const bf16* Z = (const bf16*)(P.ws + WS_RA); bf16* MIX = (bf16*)(P.ws + WS_RB); const float* ST = (const float*)(P.ws + WS_RB + 64 * MiB) + ((size_t)((b * 6 + hh) * NCH + c)) * 4096;
    const size_t row0 = (size_t)b * S + (size_t)c * 128;
    { const int s = tid >> 2, dq = tid & 3; const size_t row = row0 + s; float o1[8], o2[8];
      const float* cs = (const float*)(P.ws + WS_COS) + row * 32; const float* sn = (const float*)(P.ws + WS_SIN) + row * 32;
      load_rot(Z + row * ZP + 512 + hh * 64, cs, sn, dq, 1.0f, o1, o2);
      { u32x4 w; w.x = pk2(o1[0], o1[1]); w.y = pk2(o1[2], o1[3]); w.z = pk2(o1[4], o1[5]); w.w = pk2(o1[6], o1[7]); *(u32x4*)(Q + s * ST72 + dq * 8) = w;
        w.x = pk2(o2[0], o2[1]); w.y = pk2(o2[2], o2[3]); w.z = pk2(o2[4], o2[5]); w.w = pk2(o2[6], o2[7]); *(u32x4*)(Q + s * ST72 + 32 + dq * 8) = w; }
      load_rot(Z + row * ZP + 896 + hh * 64, cs, sn, dq, 0.125f, o1, o2);
      { u32x4 w; w.x = pk2(o1[0], o1[1]); w.y = pk2(o1[2], o1[3]); w.z = pk2(o1[4], o1[5]); w.w = pk2(o1[6], o1[7]); *(u32x4*)(K + s * ST72 + dq * 8) = w;
        w.x = pk2(o2[0], o2[1]); w.y = pk2(o2[2], o2[3]); w.z = pk2(o2[4], o2[5]); w.w = pk2(o2[6], o2[7]); *(u32x4*)(K + s * ST72 + 32 + dq * 8) = w; }
      const bf16* vp = Z + row * ZP + 1280 + hh * 64 + dq * 16; const u32x4 a = *(const u32x4*)vp, bb = *(const u32x4*)(vp + 8);
      const unsigned vv[8] = {a.x, a.y, a.z, a.w, bb.x, bb.y, bb.z, bb.w};
#pragma unroll
      for (int i = 0; i < 8; ++i) { VT[(dq * 16 + 2 * i) * ST136 + s] = (bf16)(vv[i] & 0xffffu); VT[(dq * 16 + 2 * i + 1) * ST136 + s] = (bf16)(vv[i] >> 16); }
      const int d = tid >> 3, e0 = (tid & 7) * 8; const f32x4 r0 = *(const f32x4*)(ST + d * 64 + e0), r1 = *(const f32x4*)(ST + d * 64 + e0 + 4);
#pragma unroll
      for (int i = 0; i < 4; ++i) { RT[(e0 + i) * ST72 + d] = f2bf(r0[i]); RT[(e0 + 4 + i) * ST72 + d] = f2bf(r1[i]); } }
    __syncthreads();
    for (int blk = wid; blk < 10; blk += 8) {
        const int tb = blk < 1 ? 0 : blk < 3 ? 1 : blk < 6 ? 2 : 3, sb = blk - (tb * (tb + 1)) / 2; f32x16 acc = {};
#pragma unroll
        for (int ks = 0; ks < 4; ++ks) { const bf16x8 a = *(const bf16x8*)(Q + (32 * tb + r) * ST72 + 16 * ks + 8 * h); const bf16x8 bb = *(const bf16x8*)(K + (32 * sb + r) * ST72 + 16 * ks + 8 * h); acc = MFMA32(a, bb, acc); }
#pragma unroll
        for (int i = 0; i < 16; ++i) { const int t = 32 * tb + crow(i, h), s = 32 * sb + r; const float v = s <= t ? acc[i] * __builtin_amdgcn_exp2f((float)(t - s) * lg) : 0.f; Pm[t * ST136 + s] = f2bf(v); }
    }
    __syncthreads();
    const int tb = wid >> 1, eb = wid & 1; f32x16 a1 = {}, a2 = {};
    for (int ks = 0; ks < 2 * (tb + 1); ++ks) { const bf16x8 a = *(const bf16x8*)(Pm + (32 * tb + r) * ST136 + 16 * ks + 8 * h); const bf16x8 bb = *(const bf16x8*)(VT + (32 * eb + r) * ST136 + 16 * ks + 8 * h); a1 = MFMA32(a, bb, a1); }
#pragma unroll
    for (int ks = 0; ks < 4; ++ks) { const bf16x8 a = *(const bf16x8*)(Q + (32 * tb + r) * ST72 + 16 * ks + 8 * h); const bf16x8 bb = *(const bf16x8*)(RT + (32 * eb + r) * ST72 + 16 * ks + 8 * h); a2 = MFMA32(a, bb, a2); }
    __syncthreads();
#pragma unroll
    for (int i = 0; i < 16; ++i) { const int t = 32 * tb + crow(i, h); O[t * 65 + 32 * eb + r] = a1[i] + a2[i] * __builtin_amdgcn_exp2f((float)(t + 1) * lg); }
    __syncthreads();
    { const int t = tid >> 2, eq = tid & 3; float v[16]; float ss = 0.f;
#pragma unroll
      for (int i = 0; i < 16; ++i) { v[i] = O[t * 65 + eq * 16 + i]; ss += v[i] * v[i]; }
      ss += __shfl_xor(ss, 1); ss += __shfl_xor(ss, 2);
      const float rn = rsqrtf(ss * (1.0f / 64.0f) + EPS); const size_t row = row0 + t;
      const bf16* gp = Z + row * ZP + 1664 + hh * 64 + eq * 16; const u32x4 ga = *(const u32x4*)gp, gb = *(const u32x4*)(gp + 8);
      const unsigned gg[8] = {ga.x, ga.y, ga.z, ga.w, gb.x, gb.y, gb.z, gb.w}; unsigned ow[8];
#pragma unroll
      for (int i = 0; i < 8; ++i) { const float g0 = bflo(gg[i]), g1 = bfhi(gg[i]);
          ow[i] = pk2(g0 * pg8::sigmoid_f(g0) * v[2 * i] * rn, g1 * pg8::sigmoid_f(g1) * v[2 * i + 1] * rn); }
      bf16* op = MIX + row * 1024 + 256 + hh * 64 + eq * 16;
      *(u32x4*)op = (u32x4){ow[0], ow[1], ow[2], ow[3]}; *(u32x4*)(op + 8) = (u32x4){ow[4], ow[5], ow[6], ow[7]}; }
    __syncthreads();
}
DI void fox_unit(const Params& P, int b, int hh, int qb, char* lds) {
    int tid_u = threadIdx.x; asm volatile("" : "+v"(tid_u)); const int tid = tid_u, lane = tid & 63, wid = tid >> 6, r = lane & 31, h = lane >> 5;
    bf16* Kt = (bf16*)lds; bf16* VT = Kt + 2 * 64 * ST72; float* NC = (float*)(VT + 2 * 64 * ST68);
    const bf16* Z = (const bf16*)(P.ws + WS_RA); bf16* MIX = (bf16*)(P.ws + WS_RB);
    const size_t rowb = (size_t)b * S; const int q0 = qb * 256;
    const float* c2 = (const float*)(P.ws + WS_C2) + (size_t)(b * 6 + hh) * S; const float cref = c2[q0];
    const int qrow = q0 + 32 * wid + r;
    bf16x8 qf[4];
    { const bf16* qp = Z + (rowb + qrow) * ZP + 2048 + hh * 64; const float sc = 0.125f * LOG2E;
#pragma unroll
      for (int s = 0; s < 4; ++s) { const u32x4 w = *(const u32x4*)(qp + 16 * s + 8 * h); u32x4 o;
          o.x = pk2(bflo(w.x) * sc, bfhi(w.x) * sc); o.y = pk2(bflo(w.y) * sc, bfhi(w.y) * sc); o.z = pk2(bflo(w.z) * sc, bfhi(w.z) * sc); o.w = pk2(bflo(w.w) * sc, bfhi(w.w) * sc);
          qf[s] = __builtin_bit_cast(bf16x8, o); } }
    float qn;
    { float ss = 0.f;
#pragma unroll
      for (int s = 0; s < 4; ++s) { const u32x4 w = __builtin_bit_cast(u32x4, qf[s]);
          ss += bflo(w.x) * bflo(w.x) + bfhi(w.x) * bfhi(w.x) + bflo(w.y) * bflo(w.y) + bfhi(w.y) * bfhi(w.y) + bflo(w.z) * bflo(w.z) + bfhi(w.z) * bfhi(w.z) + bflo(w.w) * bflo(w.w) + bfhi(w.w) * bfhi(w.w); }
      ss += __shfl_xor(ss, 32);
#pragma unroll
      for (int o = 1; o < 32; o <<= 1) ss = fmaxf(ss, __shfl_xor(ss, o));
      qn = sqrtf(ss) * 1.001f; }
    const float* kpms = (const float*)(P.ws + WS_KPMS) + (b * 6 + hh) * NCH;
    volatile unsigned* dflag = (volatile unsigned*)(NC + 128);
    if (tid < 8) dflag[tid] = 0u;
    bool done = false;
    f32x16 o0 = {}, o1 = {}; float m = -INFINITY, l = 0.f;
    const int ntile = 4 * (qb + 1);
    const int lrow = tid >> 3, lch = tid & 7;
    const bf16* kg = Z + (rowb + lrow) * ZP + 2432 + hh * 64 + lch * 8; const bf16* vg = Z + (rowb + lrow) * ZP + 2816 + hh * 64 + lch * 8;
    u32x4 kreg, vreg; float ncreg = 0.f;
#define FOX_LOAD(t) do { kreg = *(const u32x4*)(kg + (size_t)(t) * 64 * ZP); vreg = *(const u32x4*)(vg + (size_t)(t) * 64 * ZP); if (tid < 64) ncreg = cref - c2[64 * (t) + tid]; } while (0)
#define FOX_STORE(bufi) do { *(u32x4*)(Kt + (bufi) * 64 * ST72 + lrow * ST72 + lch * 8) = kreg; bf16* vt_ = VT + (bufi) * 64 * ST68 + (lch * 8) * ST68 + lrow; \
        vt_[0] = (bf16)(vreg.x & 0xffffu); vt_[ST68] = (bf16)(vreg.x >> 16); vt_[2 * ST68] = (bf16)(vreg.y & 0xffffu); vt_[3 * ST68] = (bf16)(vreg.y >> 16); \
        vt_[4 * ST68] = (bf16)(vreg.z & 0xffffu); vt_[5 * ST68] = (bf16)(vreg.z >> 16); vt_[6 * ST68] = (bf16)(vreg.w & 0xffffu); vt_[7 * ST68] = (bf16)(vreg.w >> 16); \
        if (tid < 64) NC[(bufi) * 64 + tid] = ncreg; } while (0)
    FOX_LOAD(ntile - 1); FOX_STORE(0); __syncthreads();
    int buf = 0;
    for (int t = ntile - 1; t >= 0; --t) {
        float c2n = 0.f, kpn = 0.f;
        if (t > 0) { FOX_LOAD(t - 1); c2n = c2[64 * t - 1]; kpn = kpms[(t - 1) >> 1]; }
        const int kv0 = 64 * t;
        if (!done && kv0 <= q0 + 32 * wid + 31) {
            const bf16* Kb = Kt + buf * 64 * ST72; const bf16* Vb = VT + buf * 64 * ST68; const float* NCb = NC + buf * 64;
            f32x16 p0 = {}, p1 = {};
#pragma unroll
            for (int s = 0; s < 4; ++s) { const bf16x8 a0 = *(const bf16x8*)(Kb + r * ST72 + 16 * s + 8 * h), a1 = *(const bf16x8*)(Kb + (32 + r) * ST72 + 16 * s + 8 * h);
                p0 = MFMA32(a0, qf[s], p0); p1 = MFMA32(a1, qf[s], p1); }
#pragma unroll
            for (int g = 0; g < 4; ++g) { const f32x4 n0 = *(const f32x4*)(NCb + 8 * g + 4 * h), n1 = *(const f32x4*)(NCb + 32 + 8 * g + 4 * h);
#pragma unroll
                for (int j = 0; j < 4; ++j) { p0[4 * g + j] += n0[j]; p1[4 * g + j] += n1[j]; } }
            if (kv0 + 63 > q0 + 32 * wid) {
#pragma unroll
                for (int i = 0; i < 16; ++i) { const int kv = kv0 + crow(i, h); if (kv > qrow) p0[i] = -INFINITY; if (kv + 32 > qrow) p1[i] = -INFINITY; } }
            float mx = fmaxf(p0[0], p1[0]);
#pragma unroll
            for (int i = 1; i < 16; ++i) mx = fmaxf(mx, fmaxf(p0[i], p1[i]));
            mx = fmaxf(mx, __shfl_xor(mx, 32));
            const float mn = fmaxf(m, mx), mu = (mn == -INFINITY) ? 0.f : mn; const float alpha = __builtin_amdgcn_exp2f(m - mu); m = mn;
            float ls = 0.f;
#pragma unroll
            for (int i = 0; i < 16; ++i) { p0[i] = __builtin_amdgcn_exp2f(p0[i] - mu); p1[i] = __builtin_amdgcn_exp2f(p1[i] - mu); ls += p0[i] + p1[i]; }
            l = l * alpha + ls;
#pragma unroll
            for (int i = 0; i < 16; ++i) { o0[i] *= alpha; o1[i] *= alpha; }
#pragma unroll
            for (int blk = 0; blk < 2; ++blk)
#pragma unroll
                for (int s = 0; s < 2; ++s) { const bf16x8 pf = blk == 0 ? pack8(p0, 8 * s) : pack8(p1, 8 * s); const int kvo = 32 * blk + 16 * s + 4 * h;
                    const u32x2 l0 = *(const u32x2*)(Vb + r * ST68 + kvo), h0 = *(const u32x2*)(Vb + r * ST68 + kvo + 8);
                    const u32x2 l1 = *(const u32x2*)(Vb + (32 + r) * ST68 + kvo), h1 = *(const u32x2*)(Vb + (32 + r) * ST68 + kvo + 8);
                    const u32x4 v0 = {l0.x, l0.y, h0.x, h0.y}, v1 = {l1.x, l1.y, h1.x, h1.y};
                    o0 = MFMA32(__builtin_bit_cast(bf16x8, v0), pf, o0); o1 = MFMA32(__builtin_bit_cast(bf16x8, v1), pf, o1); }
            if (t > 0) { float mm = m;
#pragma unroll
                for (int o = 1; o < 32; o <<= 1) mm = fminf(mm, __shfl_xor(mm, o));
                const float mmu = __uint_as_float(__builtin_amdgcn_readfirstlane(__float_as_uint(mm)));
                if (qn * kpn + (cref - c2n) < mmu - 40.0f) done = true; }
        }
        if (t > 0) FOX_STORE(buf ^ 1);
        if (done && lane == 0) dflag[wid] = 1u;
        __syncthreads();
        buf ^= 1;
        if ((dflag[0] & dflag[1] & dflag[2] & dflag[3] & dflag[4] & dflag[5] & dflag[6] & dflag[7]) != 0u) break;
    }
#undef FOX_LOAD
#undef FOX_STORE
    l += __shfl_xor(l, 32); const float inv = 1.0f / l;
    bf16* op = MIX + (rowb + qrow) * 1024 + 640 + hh * 64;
#pragma unroll
    for (int g = 0; g < 4; ++g) { u32x2 w; w.x = pk2(o0[4 * g] * inv, o0[4 * g + 1] * inv); w.y = pk2(o0[4 * g + 2] * inv, o0[4 * g + 3] * inv); *(u32x2*)(op + 8 * g + 4 * h) = w;
        w.x = pk2(o1[4 * g] * inv, o1[4 * g + 1] * inv); w.y = pk2(o1[4 * g + 2] * inv, o1[4 * g + 3] * inv); *(u32x2*)(op + 32 + 8 * g + 4 * h) = w; }
}
#ifndef PMASK
#define PMASK 0xffff
#endif
#define PEN(k) ((PMASK >> (k)) & 1)
#ifndef DUP
#define DUP 0
#endif
#ifndef XSYNC
#define XSYNC 0
#endif
#define REP(k) for (int rep_ = 0; rep_ < 1 + ((DUP >> (k)) & 1); ++rep_)
constexpr int LDS_BYTES = 147456;
constexpr int LDS_QW = 140 * 1024;
#define LAS __attribute__((address_space(3)))
#define XB_TMO      128
#define XB_XCNT(j)  (256  + 64 * (j))
#define XB_XSUB(j)  (1280 + 64 * (j))
#define XB_XGEN(j)  (2304 + 64 * (j))
#define XB_TOP      3328
#define XB_TOPGEN   3392
#define XCD_BAR_WORDS 3456
#define XB_SPIN_CAP (1u << 18)

__device__ __forceinline__ unsigned xb_ld(unsigned* p)              { return __hip_atomic_load(p, __ATOMIC_RELAXED, __HIP_MEMORY_SCOPE_AGENT); }
__device__ __forceinline__ unsigned xb_add(unsigned* p, unsigned v) { return __hip_atomic_fetch_add(p, v, __ATOMIC_RELAXED, __HIP_MEMORY_SCOPE_AGENT); }
__device__ __forceinline__ unsigned xb_xcc_id() { return (unsigned)__builtin_amdgcn_s_getreg((3 << 11) | 20) & 0xFu; }
#define XB_SPIN(cond, bar) do { unsigned _sp = 0; while (cond) { __builtin_amdgcn_s_sleep(1); \
    if ((++_sp & 255u) == 0u) { if (xb_ld(&(bar)[XB_TMO])) break; if (_sp > XB_SPIN_CAP) { atomicAdd(&(bar)[XB_TMO], 1u); break; } } } } while (0)

struct XcdBarrier {
    unsigned* bar; unsigned x;
    volatile LAS unsigned* st;
};

__device__ __forceinline__ XcdBarrier xcd_barrier_post(unsigned* bar, volatile LAS unsigned* st) {
    XcdBarrier b; b.bar = bar; b.x = xb_xcc_id(); b.st = st;
    if (threadIdx.x == 0) (void)xb_add(&bar[XB_XCNT(b.x)], 1u);
    return b;
}
__device__ __forceinline__ void xcd_barrier_complete(unsigned* bar, unsigned x, unsigned& nloc, unsigned& nx) {
    const unsigned G = gridDim.x * gridDim.y * gridDim.z;
    unsigned sum, cnt, mine, sp = 0u;
    for (;;) {
        sum = 0u; cnt = 0u; mine = 0u;
#pragma unroll
        for (unsigned j = 0; j < 16; ++j) { const unsigned c = xb_ld(&bar[XB_XCNT(j)]); sum += c; cnt += (c > 0u) ? 1u : 0u; mine = (j == x) ? c : mine; }
        if (sum == G) break;
        __builtin_amdgcn_s_sleep(1);
        if ((++sp & 255u) == 0u) { if (xb_ld(&bar[XB_TMO])) break; if (sp > XB_SPIN_CAP) { atomicAdd(&bar[XB_TMO], 1u); break; } }
    }
    nloc = mine > 0u ? mine : 1u; nx = cnt > 0u ? cnt : 1u;
}

__device__ __forceinline__ void xcd_barrier(const XcdBarrier& b) {
    asm volatile("s_waitcnt vmcnt(0)" ::: "memory");
    __syncthreads();
    if (threadIdx.x == 0) {
        unsigned* bar = b.bar;
        __builtin_amdgcn_s_waitcnt(0);
        unsigned nloc = b.st[0], nx = b.st[1];
        if (nloc == 0u) { xcd_barrier_complete(bar, b.x, nloc, nx); b.st[0] = nloc; b.st[1] = nx; }
        const unsigned old = xb_add(&bar[XB_XSUB(b.x)], 1u);
        const unsigned gen = old / nloc;
        if (old + 1u == (gen + 1u) * nloc) {
            __builtin_amdgcn_fence(__ATOMIC_RELEASE, "agent");
            asm volatile("s_waitcnt vmcnt(0)" ::: "memory");
            const unsigned og = xb_add(&bar[XB_TOP], 1u);
            const unsigned tg = og / nx;
            if (og + 1u == (tg + 1u) * nx) xb_add(&bar[XB_TOPGEN], 1u);
            else XB_SPIN(xb_ld(&bar[XB_TOPGEN]) == tg, bar);
            __builtin_amdgcn_fence(__ATOMIC_ACQUIRE, "agent");
            xb_add(&bar[XB_XGEN(b.x)], 1u);
            asm volatile("s_waitcnt vmcnt(0)" ::: "memory");
        } else {
            XB_SPIN(xb_ld(&bar[XB_XGEN(b.x)]) == gen, bar);
            __builtin_amdgcn_fence(__ATOMIC_ACQUIRE, "agent");
            asm volatile("s_waitcnt vmcnt(0)" ::: "memory");
        }
    }
    __syncthreads();
}

constexpr int CW_BAR = 4096;
constexpr int LDS_MISC = 141 * 1024;
typedef const __attribute__((address_space(4))) Params* kparams_t;
#if defined(__HIP_DEVICE_COMPILE__)
#define PH_COPY const Params P = *pp_;
#else
#define PH_COPY const Params P = Pk; const Params* pp_h = &Pk; (void)pp_h;
#endif
#define PH_BEGIN  kparams_t pp_ = (kparams_t)__builtin_amdgcn_kernarg_segment_ptr(); asm volatile("" : "+s"(pp_)); PH_COPY \
    int tid_ = threadIdx.x; asm volatile("" : "+v"(tid_)); const int tid = tid_, lane = tid & 63, wave = __builtin_amdgcn_readfirstlane(tid >> 6); \
    const int G = gridDim.x, bx = blockIdx.x, gw = bx * 8 + wave, NGW = G * 8; unsigned char* ws = P.ws; (void)lane; (void)gw; (void)NGW; (void)ws; \
    PG8_LAS unsigned char* L = (PG8_LAS unsigned char*)lds; (void)L;
#define GRID_SYNC() do { kparams_t pg_ = (kparams_t)__builtin_amdgcn_kernarg_segment_ptr(); XcdBarrier xb_; xb_.bar = (unsigned*)(pg_->ws + WS_CTL) + CW_BAR; xb_.x = xb_xcc_id(); \
    xb_.st = (volatile LAS unsigned*)((LAS unsigned char*)lds + LDS_MISC); xcd_barrier(xb_); } while (0)
#ifndef BF16_STREAM
#define BF16_STREAM 1
#endif
#if BF16_STREAM
#define RS_SRC ((const float*)nullptr)
#define RS_DST ((float*)nullptr)
#else
#define RS_SRC ((const float*)P.out)
#define RS_DST (P.out)
#endif
#define WSP(T_, off) ((T_*)(ws + (off)))
__global__ void __launch_bounds__(512, 2) fwd_kernel(Params Pk) {
    extern __shared__ __attribute__((aligned(16))) unsigned char lds[];
    cg::grid_group grid = cg::this_grid();
    { volatile LAS unsigned* st = (volatile LAS unsigned*)((LAS unsigned char*)lds + LDS_MISC);
      if (threadIdx.x < 2) st[threadIdx.x] = 0u;
      __syncthreads();
      kparams_t pq_ = (kparams_t)__builtin_amdgcn_kernarg_segment_ptr();
      (void)xcd_barrier_post((unsigned*)(pq_->ws + WS_CTL) + CW_BAR, st); }
    { PH_BEGIN
      convert_weights(P, 0, (char*)lds, gw, NGW, wave, lane);
      rope_table(P, bx * 512 + tid, G * 512);
      resid_rows(P, P.in[I_X], nullptr, nullptr, nullptr, gw, NGW, lane); }
    asm volatile("s_waitcnt vmcnt(0) lgkmcnt(0)" ::: "memory"); grid.sync(); __builtin_amdgcn_fence(__ATOMIC_ACQUIRE, "agent"); asm volatile("s_waitcnt vmcnt(0)" ::: "memory");
    for (int layer = 0; layer < DEPTH; ++layer) {
        if (PEN(1)) REP(1) { PH_BEGIN
          pg8::Gemm g{WSP(bf16, WS_XB), WSP(const bf16, WS_W + W_IN), T, ZP, 1024}; pg8::StaticOrder So; So.init(T, ZP, G, bx);
          pg8::EpiZ E{WSP(bf16, WS_RA), WSP(float, WS_RINVX), WSP(float, WS_LF), P.in[I_FOXB] + layer * 6};
          pg8::gemm_phase<pg8::EpiZ, pg8::StaticOrder, true, true>(L, g, So, E); }
        GRID_SYNC();
        if (PEN(2)) REP(2) { PH_BEGIN
          for (int u = bx; u < 1024 + 1536 + 256; u += G) {
            if (u < 1024) { sgu_unit(P, layer, u >> 9, (u >> 2) & 127, u & 3, (char*)lds); }
            else if (u < 2560) { const int v = u - 1024, bh = v / NCH, c = v % NCH; ret1_unit(P, pp_->lg2gam[bh % 6], bh / 6, bh % 6, c, (char*)lds); }
            else { const int v = u - 2560; cum_unit(P, v >> 7, v & 127); } } }
        GRID_SYNC();
        if (PEN(3)) { PH_BEGIN
          float* ST = (float*)(ws + WS_RB + 64 * MiB);
          for (int e = bx * 512 + tid; e < 12 * 4096; e += G * 512) { const int bh = e >> 12, de = e & 4095; const float g128 = __builtin_amdgcn_exp2f(128.0f * pp_->lg2gam[bh % 6]);
              float* p = ST + (size_t)bh * NCH * 4096 + de; float carry = 0.f;
              for (int c0 = 0; c0 < NCH; c0 += 32) { float sv[32];
#pragma unroll
                  for (int j = 0; j < 32; ++j) sv[j] = p[(size_t)(c0 + j) * 4096];
#pragma unroll
                  for (int j = 0; j < 32; ++j) { p[(size_t)(c0 + j) * 4096] = carry; carry = carry * g128 + sv[j]; } } }
          if (bx >= G - 12) { const int bh = bx - (G - 12);
              const float* CT = (const float*)(ws + WS_CT); const float* CL = (const float*)(ws + WS_CL); float* C2 = (float*)(ws + WS_C2); const float* KN = (const float*)(ws + WS_KN);
              float* pre = (float*)lds;
              if (tid < 128) { const float v = CT[bh * NCH + tid]; float x = v, km = KN[bh * NCH + tid];
#pragma unroll
                  for (int o = 1; o < 64; o <<= 1) { const float y = __shfl_up(x, o), z = __shfl_up(km, o); if (lane >= o) { x += y; km = fmaxf(km, z); } }
                  pre[tid] = x - v; pre[128 + tid] = x; pre[256 + tid] = km; }
              __syncthreads();
              if (tid >= 64 && tid < 128) { pre[tid] += pre[128 + 63]; pre[256 + tid] = fmaxf(pre[256 + tid], pre[256 + 63]); }
              __syncthreads();
              if (tid < 128) ((float*)(ws + WS_KPMS))[bh * NCH + tid] = sqrtf(pre[256 + tid]);
              for (int i = tid; i < S; i += 512) C2[(size_t)bh * S + i] = (pre[i >> 7] + CL[(size_t)bh * S + i]) * LOG2E;
              __syncthreads(); } }
        GRID_SYNC();
        if (PEN(4)) REP(4) { PH_BEGIN
          unsigned* qctr = WSP(unsigned, WS_CTL) + 64 * (1 + layer) + 256 * rep_; volatile unsigned* qw = (volatile unsigned*)(lds + LDS_QW);
          for (;;) { if (tid == 0) *qw = atomicAdd(qctr, 1u);
              __syncthreads(); const unsigned u = *qw; __syncthreads();
              if (u >= 768u + 1536u) break;
              if (u < 768u) { const int qb = 63 - (int)(u / 12u), bh = (int)(u % 12u); fox_unit(P, bh / 6, bh % 6, qb, (char*)lds); }
              else { const int v = (int)u - 768, bh = v / NCH, c = v % NCH; ret3_unit(P, pp_->lg2gam[bh % 6], bh / 6, bh % 6, c, (char*)lds); } } }
        GRID_SYNC();
        if (PEN(5)) REP(5) { PH_BEGIN
          pg8::Gemm g{WSP(bf16, WS_RB), WSP(const bf16, WS_W + W_O), T, 1024, 1024}; pg8::StaticOrder So; So.init(T, 1024, G, bx);
          pg8::EpiY E{WSP(bf16, WS_RA), WSP(float, WS_SSQP), 1024}; pg8::gemm_phase<pg8::EpiY, pg8::StaticOrder, true, true>(L, g, So, E); }
        GRID_SYNC();
        { PH_BEGIN
          resid_rows(P, layer == 0 ? P.in[I_X] : RS_SRC, RS_DST, WSP(bf16, WS_RA), P.in[I_MIXPOST] + layer * 1024, gw, NGW, lane); }
        GRID_SYNC();
        if (PEN(7)) for (int st = 0; st < 5; ++st) { REP(7) {
            if (st == 2 || st == 4) { PH_BEGIN
                const int hb = (st - 2) >> 1;
                pg8::Gemm g{WSP(bf16, WS_RA) + (size_t)S * DFF, WSP(const bf16, WS_W + W_D), S, 1024, DFF}; pg8::StaticOrder So; So.init(S, 1024, G, bx);
                pg8::EpiY E{WSP(bf16, WS_RB) + (size_t)hb * S * 1024, WSP(float, WS_SSQP) + (size_t)hb * S * 16, 1024}; pg8::gemm_phase<pg8::EpiY, pg8::StaticOrder, true, true>(L, g, So, E); }
            if (st == 0 || st == 2) { PH_BEGIN
                const int hb = st >> 1;
                pg8::Gemm g{WSP(bf16, WS_XB) + (size_t)hb * S * 1024, WSP(const bf16, WS_W + W_G), S, DFF, 1024}; pg8::StaticOrder So; So.init(S, DFF, G, bx);
                pg8::EpiS E{WSP(bf16, WS_RA), WSP(float, WS_RINVX) + hb * S, DFF}; pg8::gemm_phase<pg8::EpiS, pg8::StaticOrder, true, true>(L, g, So, E); }
            if (st == 1 || st == 3) { PH_BEGIN
                const int hb = st >> 1;
                pg8::Gemm g{WSP(bf16, WS_XB) + (size_t)hb * S * 1024, WSP(const bf16, WS_W + W_U), S, DFF, 1024}; pg8::StaticOrder So; So.init(S, DFF, G, bx);
                pg8::EpiAct E{WSP(bf16, WS_RA) + (size_t)S * DFF, WSP(const bf16, WS_RA), WSP(float, WS_RINVX) + hb * S, P.in[I_CONVW] + (size_t)layer * 3 * DFF, P.in[I_CONVB] + (size_t)layer * DFF};
                pg8::gemm_phase<pg8::EpiAct, pg8::StaticOrder, true, true>(L, g, So, E); }
            }
            GRID_SYNC();
        }
        if (PEN(10)) REP(10) { PH_BEGIN
          int kd_ = 256; asm volatile("" : "+s"(kd_));
          pg8::Gemm g{WSP(const bf16, WS_PB), WSP(const bf16, WS_W + W_PP), T, 1024, kd_}; pg8::StaticOrder So; So.init(T, 1024, G, bx);
          pg8::EpiS E{WSP(bf16, WS_RA), nullptr, 1024}; pg8::gemm_phase<pg8::EpiS, pg8::StaticOrder, true, true>(L, g, So, E); }
        { PH_BEGIN
          resid_rows(P, RS_SRC, RS_DST, WSP(bf16, WS_RB), P.in[I_FFNPOST] + layer * 1024, gw, NGW, lane); }
        GRID_SYNC();
        if (PEN(11)) REP(11) { PH_BEGIN
          pg8::Gemm g{WSP(bf16, WS_XB), WSP(const bf16, WS_W + W_PG), T, 1024, 1024}; pg8::StaticOrder So; So.init(T, 1024, G, bx);
          pg8::EpiPle E{WSP(bf16, WS_RB), WSP(const bf16, WS_RA), WSP(float, WS_RINVX), WSP(float, WS_SSQP)}; pg8::gemm_phase<pg8::EpiPle, pg8::StaticOrder, true, true>(L, g, So, E); }
        GRID_SYNC();
        { PH_BEGIN
          resid_rows(P, RS_SRC, (layer == DEPTH - 1) ? P.out : RS_DST, WSP(bf16, WS_RB), P.in[I_PLEPOST] + layer * 1024, gw, NGW, lane);
          if (layer + 1 < DEPTH) { __syncthreads(); convert_weights(P, layer + 1, (char*)lds, gw, NGW, wave, lane); } }
        if (layer + 1 < DEPTH) GRID_SYNC();
        for (int xs_ = 0; xs_ < XSYNC; ++xs_) GRID_SYNC();
#ifdef XRESID
        for (int xr_ = 0; xr_ < XRESID; ++xr_) { { PH_BEGIN resid_rows(P, P.out, P.out, nullptr, nullptr, gw, NGW, lane); } GRID_SYNC(); }
#endif
    }
}

extern "C" void kernel_launch(void* const* d_in, const int* in_sizes, int n_in, void* d_out, int out_size, void* d_ws, size_t ws_size, hipStream_t stream) {
    static int grid = 0;
    if (grid == 0) {
        if (n_in != N_INPUTS || ws_size < WS_END) { fprintf(stderr, "kernel_launch: unexpected n_in %d / ws_size %zu\n", n_in, ws_size); grid = -1; return; }
        int dev = 0, cus = 0, per_cu = 0;
        (void)hipGetDevice(&dev); (void)hipDeviceGetAttribute(&cus, hipDeviceAttributeMultiprocessorCount, dev);
        (void)hipFuncSetAttribute((const void*)fwd_kernel, hipFuncAttributeMaxDynamicSharedMemorySize, LDS_BYTES);
        (void)hipOccupancyMaxActiveBlocksPerMultiprocessor(&per_cu, (const void*)fwd_kernel, 512, LDS_BYTES);
        if (per_cu < 1) { fprintf(stderr, "kernel_launch: occupancy query says %d blocks/CU\n", per_cu); per_cu = 1; }
        grid = cus;
    }
    if (grid < 0) return;
    (void)hipMemsetAsync((char*)d_ws + WS_CTL, 0, 65536, stream);
    Params p; memset(&p, 0, sizeof(p));
    for (int i = 0; i < N_INPUTS; ++i) p.in[i] = (const float*)d_in[i];
    p.out = (float*)d_out; p.ws = (unsigned char*)d_ws;
    for (int h = 0; h < 6; ++h) p.lg2gam[h] = (float)log2(1.0 - exp2(-5.0 - (double)h));
    void* args[] = {&p};
    hipError_t e = hipLaunchCooperativeKernel((const void*)fwd_kernel, dim3(grid), dim3(512), args, LDS_BYTES, stream);
    if (e != hipSuccess) fprintf(stderr, "cooperative launch failed: %s (grid %d)\n", hipGetErrorString(e), grid);
}
```
